# Optimizing an MI355X kernel written in HIP

```python
import math
import jax, jax.numpy as jnp
from jax import lax
import numpy as np

D_MODEL = 1024
BATCH = 8
SEQ = 2048
DEPTH = 1
DEC_BATCH = 128
DEC_SEQ = 4
PAST_LEN = 16384
PAGE_SIZE = 128

D_FF = 2816
CONV_CH = 512
CONV_WIDTH = 31
GDN_HEADS = 4
GDN_DK = 128
GDN_DV = 128
QK_DIM = GDN_HEADS * GDN_DK
V_DIM = GDN_HEADS * GDN_DV
QKV_DIM = 2 * QK_DIM + V_DIM
SHORT_CONV_WIDTH = 4
GDN_CHUNK = 64
MIX_WIDTH = CONV_CH + V_DIM
PROJ_WIDTH = 2 * CONV_CH + QKV_DIM + V_DIM + 2 * GDN_HEADS
LN_EPS = 1e-5
RMS_EPS = 1e-6
DEEPNORM_ALPHA = (2.0 * DEPTH) ** 0.25
DEEPNORM_BETA = (8.0 * DEPTH) ** -0.25

kernel_name = "hymba_conformer_gdn_macaron_deepnorm_step"


def _layer_norm(x, g, b):
    x32 = x.astype(jnp.float32)
    mu = jnp.mean(x32, axis=-1, keepdims=True)
    var = jnp.mean(jnp.square(x32 - mu), axis=-1, keepdims=True)
    return ((x32 - mu) * lax.rsqrt(var + LN_EPS) * g.astype(jnp.float32) + b.astype(jnp.float32)).astype(x.dtype)


def _swiglu(x, w_up, w_down):
    a, b = jnp.split(x @ w_up, 2, axis=-1)
    return (jax.nn.silu(a) * b) @ w_down


def _causal_dwconv(x, buf, w):
    ch = x.shape[-1]
    width = w.shape[0]
    xp = jnp.concatenate([buf.astype(x.dtype), x], axis=1)
    y = lax.conv_general_dilated(xp, w.astype(x.dtype)[:, None, :], window_strides=(1,), padding='VALID',
                                 dimension_numbers=('NWC', 'WIO', 'NWC'), feature_group_count=ch)
    return y, xp[:, xp.shape[1] - (width - 1):]


def _l2norm(x):
    x32 = x.astype(jnp.float32)
    return x32 * lax.rsqrt(jnp.sum(jnp.square(x32), axis=-1, keepdims=True) + RMS_EPS)


def _gated_delta_chunked(q, k, v, g, beta, s0):
    f32 = jnp.float32
    B, T, H, DK = q.shape
    DV = v.shape[-1]
    C = min(GDN_CHUNK, T)
    pad = (-T) % C
    q = q.astype(f32) * (DK ** -0.5)
    k = k.astype(f32)
    v = v.astype(f32)
    g = g.astype(f32)
    beta = beta.astype(f32)
    if pad:
        pw = ((0, 0), (0, pad), (0, 0), (0, 0))
        q, k, v = jnp.pad(q, pw), jnp.pad(k, pw), jnp.pad(v, pw)
        g, beta = jnp.pad(g, pw[:3]), jnp.pad(beta, pw[:3])
    N = (T + pad) // C

    def chunks(a):
        return a.reshape(B, N, C, H, a.shape[-1]).transpose(0, 3, 1, 2, 4)

    qc, kc, vc = chunks(q), chunks(k), chunks(v)
    gc = g.reshape(B, N, C, H).transpose(0, 3, 1, 2)
    bc = beta.reshape(B, N, C, H).transpose(0, 3, 1, 2)
    gcum = jnp.cumsum(gc, axis=-1)
    idx = jnp.arange(C)
    causal = idx[:, None] >= idx[None, :]
    strict = idx[:, None] > idx[None, :]
    decay = jnp.exp(jnp.where(causal, gcum[..., :, None] - gcum[..., None, :], -jnp.inf))
    k_beta = kc * bc[..., None]
    v_beta = vc * bc[..., None]
    a_mat = jnp.where(strict, jnp.einsum('bhnid,bhnjd->bhnij', k_beta, kc) * decay, 0.0)
    m = a_mat + jnp.eye(C, dtype=f32)
    rhs = jnp.concatenate([v_beta, k_beta * jnp.exp(gcum)[..., None]], axis=-1)
    sol = lax.linalg.triangular_solve(m, rhs, left_side=True, lower=True, unit_diagonal=True)
    u, w = sol[..., :DV], sol[..., DV:]
    qk = jnp.einsum('bhnid,bhnjd->bhnij', qc, kc) * decay

    def step(s, xs):
        q_i, k_i, u_i, w_i, qk_i, g_i = xs
        v_new = u_i - jnp.einsum('bhck,bhkv->bhcv', w_i, s)
        o_i = (jnp.einsum('bhck,bhkv->bhcv', q_i * jnp.exp(g_i)[..., None], s)
               + jnp.einsum('bhij,bhjv->bhiv', qk_i, v_new))
        g_last = g_i[..., -1]
        s = (s * jnp.exp(g_last)[..., None, None]
             + jnp.einsum('bhck,bhcv->bhkv', k_i * jnp.exp(g_last[..., None] - g_i)[..., None], v_new))
        return s, o_i

    xs = (jnp.moveaxis(qc, 2, 0), jnp.moveaxis(kc, 2, 0), jnp.moveaxis(u, 2, 0),
          jnp.moveaxis(w, 2, 0), jnp.moveaxis(qk, 2, 0), jnp.moveaxis(gcum, 2, 0))
    s_final, o = lax.scan(step, s0.astype(f32), xs)
    o = o.transpose(1, 0, 3, 2, 4).reshape(B, N * C, H, DV)[:, :T]
    return o, s_final


def _layer(x, conv_buf, qkv_buf, s0, ffn1_w_up, ffn1_w_down, ln1_g, ln1_b, w_in, conv_w, conv_b,
           conv_ln_g, conv_ln_b, qkv_conv_w, a_log, dt_bias, gdn_norm_g, w_out, ln2_g, ln2_b,
           ffn2_w_up, ffn2_w_down, ln3_g, ln3_b):
    B, T, _ = x.shape
    f32 = jnp.float32
    x = _layer_norm(DEEPNORM_ALPHA * x + 0.5 * _swiglu(x, ffn1_w_up, ffn1_w_down), ln1_g, ln1_b)
    h = x @ w_in
    sizes = [CONV_CH, CONV_CH, QKV_DIM, V_DIM, GDN_HEADS, GDN_HEADS]
    cuts = [int(c) for c in np.cumsum(sizes)[:-1]]
    a_val, a_gate, qkv, z, b_logit, a_logit = jnp.split(h, cuts, axis=-1)
    u = a_val * jax.nn.sigmoid(a_gate)
    c, conv_buf_new = _causal_dwconv(u, conv_buf, conv_w)
    c = jax.nn.silu(_layer_norm(c + conv_b, conv_ln_g, conv_ln_b))
    qkv, qkv_buf_new = _causal_dwconv(qkv, qkv_buf, qkv_conv_w)
    qkv = jax.nn.silu(qkv)
    q, k, v = jnp.split(qkv, [QK_DIM, 2 * QK_DIM], axis=-1)
    q = _l2norm(q.reshape(B, T, GDN_HEADS, GDN_DK))
    k = _l2norm(k.reshape(B, T, GDN_HEADS, GDN_DK))
    v = v.reshape(B, T, GDN_HEADS, GDN_DV)
    beta = jax.nn.sigmoid(b_logit.astype(f32))
    g = -jnp.exp(a_log.astype(f32)) * jax.nn.softplus(a_logit.astype(f32) + dt_bias.astype(f32))
    o, s_new = _gated_delta_chunked(q, k, v, g, beta, s0)
    o = o * lax.rsqrt(jnp.mean(jnp.square(o), axis=-1, keepdims=True) + RMS_EPS) * gdn_norm_g.astype(f32)
    o = o * jax.nn.silu(z.astype(f32).reshape(B, T, GDN_HEADS, GDN_DV))
    o = o.reshape(B, T, V_DIM).astype(x.dtype)
    mix = jnp.concatenate([c, o], axis=-1) @ w_out
    x = _layer_norm(DEEPNORM_ALPHA * x + mix, ln2_g, ln2_b)
    x = _layer_norm(DEEPNORM_ALPHA * x + 0.5 * _swiglu(x, ffn2_w_up, ffn2_w_down), ln3_g, ln3_b)
    return x, conv_buf_new, qkv_buf_new, s_new.astype(s0.dtype)


def setup_inputs(seed: int = 0) -> dict:
    key = jax.random.key(seed)
    ks = jax.random.split(key, 32)
    L = DEPTH

    def nrm(k, shape, scale):
        return jax.random.normal(k, shape, jnp.float32) * scale

    dt = jnp.exp(jax.random.uniform(ks[20], (L, GDN_HEADS), jnp.float32, math.log(1e-3), math.log(1e-1)))
    return {
        "x_prompt": nrm(ks[0], (BATCH, SEQ, D_MODEL), 1.0),
        "x_sample": nrm(ks[1], (DEC_BATCH, DEC_SEQ, D_MODEL), 1.0),
        "state_conv": nrm(ks[2], (L, DEC_BATCH, CONV_WIDTH - 1, CONV_CH), 0.5),
        "state_qkv_conv": nrm(ks[3], (L, DEC_BATCH, SHORT_CONV_WIDTH - 1, QKV_DIM), 0.5),
        "state_recurrent": nrm(ks[4], (L, DEC_BATCH, GDN_HEADS, GDN_DK, GDN_DV), 0.3),
        "ffn1_w_up": nrm(ks[5], (L, D_MODEL, 2 * D_FF), D_MODEL ** -0.5),
        "ffn1_w_down": nrm(ks[6], (L, D_FF, D_MODEL), DEEPNORM_BETA * D_FF ** -0.5),
        "ln1_g": 1.0 + nrm(ks[7], (L, D_MODEL), 0.02),
        "ln1_b": nrm(ks[8], (L, D_MODEL), 0.02),
        "w_in": nrm(ks[9], (L, D_MODEL, PROJ_WIDTH), D_MODEL ** -0.5),
        "conv_w": nrm(ks[10], (L, CONV_WIDTH, CONV_CH), CONV_WIDTH ** -0.5),
        "conv_b": nrm(ks[11], (L, CONV_CH), 0.02),
        "conv_ln_g": 1.0 + nrm(ks[12], (L, CONV_CH), 0.02),
        "conv_ln_b": nrm(ks[13], (L, CONV_CH), 0.02),
        "qkv_conv_w": nrm(ks[14], (L, SHORT_CONV_WIDTH, QKV_DIM), SHORT_CONV_WIDTH ** -0.5),
        "a_log": jnp.log(jax.random.uniform(ks[15], (L, GDN_HEADS), jnp.float32, 1.0, 16.0)),
        "dt_bias": dt + jnp.log(-jnp.expm1(-dt)),
        "gdn_norm_g": 1.0 + nrm(ks[16], (L, GDN_DV), 0.02),
        "w_out": nrm(ks[17], (L, MIX_WIDTH, D_MODEL), DEEPNORM_BETA * MIX_WIDTH ** -0.5),
        "ln2_g": 1.0 + nrm(ks[18], (L, D_MODEL), 0.02),
        "ln2_b": nrm(ks[19], (L, D_MODEL), 0.02),
        "ffn2_w_up": nrm(ks[21], (L, D_MODEL, 2 * D_FF), D_MODEL ** -0.5),
        "ffn2_w_down": nrm(ks[22], (L, D_FF, D_MODEL), DEEPNORM_BETA * D_FF ** -0.5),
        "ln3_g": 1.0 + nrm(ks[23], (L, D_MODEL), 0.02),
        "ln3_b": nrm(ks[24], (L, D_MODEL), 0.02),
    }


def reference(x_prompt, x_sample, state_conv, state_qkv_conv, state_recurrent,
              ffn1_w_up, ffn1_w_down, ln1_g, ln1_b, w_in, conv_w, conv_b, conv_ln_g, conv_ln_b,
              qkv_conv_w, a_log, dt_bias, gdn_norm_g, w_out, ln2_g, ln2_b,
              ffn2_w_up, ffn2_w_down, ln3_g, ln3_b):
    dt_ = x_prompt.dtype
    yp, ys = x_prompt, x_sample
    conv_p, qkvc_p, rec_p, conv_s, qkvc_s, rec_s = [], [], [], [], [], []
    for l in range(DEPTH):
        weights = (ffn1_w_up[l], ffn1_w_down[l], ln1_g[l], ln1_b[l], w_in[l], conv_w[l], conv_b[l],
                   conv_ln_g[l], conv_ln_b[l], qkv_conv_w[l], a_log[l], dt_bias[l], gdn_norm_g[l],
                   w_out[l], ln2_g[l], ln2_b[l], ffn2_w_up[l], ffn2_w_down[l], ln3_g[l], ln3_b[l])
        zc = jnp.zeros((BATCH, CONV_WIDTH - 1, CONV_CH), dt_)
        zq = jnp.zeros((BATCH, SHORT_CONV_WIDTH - 1, QKV_DIM), dt_)
        zs = jnp.zeros((BATCH, GDN_HEADS, GDN_DK, GDN_DV), dt_)
        yp, c1, q1, s1 = _layer(yp, zc, zq, zs, *weights)
        ys, c2, q2, s2 = _layer(ys, state_conv[l], state_qkv_conv[l], state_recurrent[l], *weights)
        conv_p.append(c1); qkvc_p.append(q1); rec_p.append(s1)
        conv_s.append(c2); qkvc_s.append(q2); rec_s.append(s2)
    return (yp, ys,
            jnp.stack(conv_p), jnp.stack(qkvc_p), jnp.stack(rec_p),
            jnp.stack(conv_s), jnp.stack(qkvc_s), jnp.stack(rec_s))
```

```cpp
#include <hip/hip_runtime.h>
#include <cstdio>
#include <cstdint>

namespace pg8 {
#define PG8_LAS __attribute__((address_space(3)))
typedef unsigned short bf16_t;
typedef short bf16x8 __attribute__((ext_vector_type(8)));
typedef float f32x4 __attribute__((ext_vector_type(4)));
typedef unsigned u32x4 __attribute__((ext_vector_type(4)));
constexpr int BM = 256, BK = 64, HALF = 128, HTB = HALF * BK * 2  , STAGE_BYTES = 8 * HTB, NXCD = 8, WGM = 8;

__host__ __device__ __forceinline__ int lds_byte(int r, int c) { const int st = (r >> 4) * 2 + (c >> 5), rr = r & 15, cc = c & 31, ob = rr * 64 + cc * 2; return st * 1024 + (ob ^ (((ob >> 9) & 1) << 5)); }
__host__ __device__ __forceinline__ void stage_rc(int b, int& R, int& C) { const int st = b / 1024, sb = b % 1024, swz = sb ^ (((sb >> 9) & 1) << 5); R = (st >> 1) * 16 + swz / 64; C = (st & 1) * 32 + (swz % 64) / 2; }
__host__ __device__ __forceinline__ int perm32(int rho) { const int n = rho >> 4, i = rho & 15; return 8 * (i >> 2) + 4 * n + (i & 3); }

struct Unit { int pm, pn, row0, nai, bjm, k0, ntk, slab; };
struct Gemm { const bf16_t* A; const bf16_t* Bt; int M, N, K; };

struct StaticOrder {
    int nM, nN, nwg, G, c;
    __host__ __device__ void init(int M, int N, int G_, int c_) { nM = M / BM; nN = N / BM; nwg = nM * nN; G = G_; c = c_; }
    __host__ __device__ bool next(int i, Unit& u) const {
        const long L = (long)i * G + c; if (L >= nwg) return false;
        int wgid = (int)L; { const int q = nwg / NXCD, r = nwg % NXCD, xcd = wgid % NXCD, off = wgid / NXCD; wgid = (xcd < r ? xcd * (q + 1) : r * (q + 1) + (xcd - r) * q) + off; }
        const int nig = WGM * nN, gid = wgid / nig, fm = gid * WGM, gsz = (nM - fm) < WGM ? (nM - fm) : WGM;
        u.pm = fm + ((wgid % nig) % gsz); u.pn = (wgid % nig) / gsz; u.row0 = u.pm * BM; u.nai = 2; u.bjm = 3; u.k0 = 0; u.ntk = 0; u.slab = -1; return true;
    }
    __device__ __forceinline__ void a_ready(const Unit&) const {}
    __device__ __forceinline__ void done(const Unit&) const {}
};

struct AlignedInOrder {
    StaticOrder so; int c; bool special; unsigned* cnt;
    __host__ __device__ static int tile_of(int p) { return p == 0 ? 12 : (p <= 6 ? p + 3 : (p <= 8 ? p + 3 : p - 9)); }
    __host__ __device__ void init(int M, int N, int G_, int c_, unsigned* cnt_) { c = c_; cnt = cnt_; special = (G_ == 256 && M == 66 * BM && N == 13 * BM); so.init(M, N, G_, c_); }
    __host__ __device__ bool next(int i, Unit& u) const {
        if (!special) return so.next(i, u);
        const int xcd = c & 7, pos = c >> 3;
        if (i >= 2 && pos >= 22) return false;
        const int l = i < 2 ? 32 * i + pos : 64 + 22 * (i - 2) + pos;
        if (i >= 4) return false;
        if (l < 104) { u.pm = 8 * xcd + (l & 7); u.pn = tile_of(l >> 3); }
        else { const int sidx = (l - 104) * 8 + xcd; if (l >= 108 || sidx >= 26) return false; u.pm = 64 + sidx / 13; u.pn = tile_of(sidx % 13); }
        u.row0 = u.pm * BM; u.nai = 2; u.bjm = 3; u.k0 = 0; u.ntk = 0; u.slab = -1; return true;
    }
    __device__ __forceinline__ void a_ready(const Unit&) const {}
    __device__ __forceinline__ void done(const Unit& u) const {
        if (special && u.pm < 64 && (u.pm & 7) < 2 && (u.pn == 12 || (u.pn >= 4 && u.pn <= 9))) {
            asm volatile("s_waitcnt vmcnt(0)" ::: "memory");
            if ((threadIdx.x & 63) == 0) __hip_atomic_fetch_add(cnt + 16 * (u.pm >> 3), 1u, __ATOMIC_RELAXED, __HIP_MEMORY_SCOPE_AGENT);
        }
    }
};

struct TailOrder {
    StaticOrder so; int nfull_rounds, G, c, M, N, mode; bool special;
    __host__ __device__ void init(int M_, int N_, int G_, int c_, int mode_ = 0) { M = M_; N = N_; G = G_; c = c_; mode = mode_; special = (G_ == 256 && N_ == 1024 && M_ == 66 * BM);
        if (special) so.init(64 * BM, N_, G_, c_); else so.init(M_, N_, G_, c_); }
    __host__ __device__ bool next(int i, Unit& u) const {
        if (!special) return so.next(i, u);
        if (mode == 2) { if (i != 0) return false; i = 1; } else { if (i == 0) return so.next(0, u); if (mode == 1) return false; }
        if (i == 1 && mode == 3) {
            if (c >= 128) return false;
            const int q = c >> 2, sl = c & 3; u.pm = 64 + (q >> 4); u.pn = (q >> 1) & 3; u.row0 = 64 * BM + (q >> 3) * HALF; u.nai = 1; u.bjm = 1 << (q & 1);
            u.k0 = sl == 0 ? 0 : (sl == 1 ? 12 : (sl == 2 ? 22 : 34)); u.ntk = (sl & 1) ? 10 : 12; u.slab = sl; return true; }
        if (i == 1 && c < 32) { u.pm = 64 + (c >> 4); u.pn = (c >> 1) & 3; u.row0 = 64 * BM + (c >> 3) * HALF; u.nai = 1; u.bjm = 1 << (c & 1); u.k0 = 0; u.ntk = 0; u.slab = -1; return true; }
        return false;
    }
    __device__ __forceinline__ void a_ready(const Unit&) const {}
    __device__ __forceinline__ void done(const Unit&) const {}
};

typedef float f32x2 __attribute__((ext_vector_type(2)));
typedef __bf16 bf16x2_t __attribute__((ext_vector_type(2)));
__device__ __forceinline__ unsigned cvt_pk_bf16(float lo, float hi) { const f32x2 v = {lo, hi}; return __builtin_bit_cast(unsigned, __builtin_convertvector(v, bf16x2_t)); }
typedef unsigned u32x2 __attribute__((ext_vector_type(2)));
constexpr float DN_ALPHA = 1.189207115002721f;
__device__ __forceinline__ float silu_f(float x) { return x * __builtin_amdgcn_rcpf(1.0f + __expf(-x)); }
__device__ __forceinline__ void row_stats(const float* st, int row, float& mean, float& rstd) {
    const f32x2 v = *(const f32x2*)(st + 2 * (size_t)row);
    mean = v.x * (1.0f / 1024.0f); const float var = v.y * (1.0f / 1024.0f) - mean * mean; rstd = rsqrtf(fmaxf(var, 0.f) + 1e-5f);
}

template <bool FOLD> struct EpiSwiGLU {
    static constexpr bool PERM = true, AFTER_DRAIN = false;
    bf16_t* O; const float* st; const float* cs; const float* bw;
    __device__ __forceinline__ void operator()(const f32x4 (&acc)[2][2][4][2], const Unit& u, int wr, int wc, int fr, int fq) const {
        const int row0 = u.row0 + wr * 64 + fr, cl = wc * 32 + 8 * fq;
        f32x4 csv[2][2], bwv[2][2];
        if (FOLD) {
#pragma unroll
            for (int bj = 0; bj < 2; ++bj)
#pragma unroll
                for (int n = 0; n < 2; ++n) { csv[bj][n] = *(const f32x4*)(cs + u.pn * BM + bj * HALF + cl + 4 * n); bwv[bj][n] = *(const f32x4*)(bw + u.pn * BM + bj * HALF + cl + 4 * n); }
        }
#pragma unroll
        for (int ai = 0; ai < 2; ++ai) if (ai < u.nai)
#pragma unroll
            for (int m = 0; m < 4; ++m) {
                const int row = row0 + ai * HALF + m * 16;
                float mean = 0.f, rstd = 1.f; if (FOLD) row_stats(st, row, mean, rstd);
                const float mr = mean * rstd;
                u32x4 w;
#pragma unroll
                for (int n = 0; n < 2; ++n) {
                    f32x4 a = acc[ai][0][m][n], b = acc[ai][1][m][n];
                    if (FOLD) { a = a * rstd - csv[0][n] * mr + bwv[0][n]; b = b * rstd - csv[1][n] * mr + bwv[1][n]; }
                    const float h0 = silu_f(a[0]) * b[0], h1 = silu_f(a[1]) * b[1], h2 = silu_f(a[2]) * b[2], h3 = silu_f(a[3]) * b[3];
                    if (n == 0) { w.x = cvt_pk_bf16(h0, h1); w.y = cvt_pk_bf16(h2, h3); } else { w.z = cvt_pk_bf16(h0, h1); w.w = cvt_pk_bf16(h2, h3); }
                }
                *(u32x4*)(O + (size_t)row * 2816 + u.pn * HALF + cl) = w;
            }
    }
};

struct EpiH {
    static constexpr bool PERM = true, AFTER_DRAIN = false;
    bf16_t* H; float* gates; const float* st; const float* cs; const float* bw; const float* gn;
    __device__ __forceinline__ void operator()(const f32x4 (&acc)[2][2][4][2], const Unit& u, int wr, int wc, int fr, int fq) const {
        const int row0 = u.row0 + wr * 64 + fr, cl = wc * 32 + 8 * fq;
        f32x4 csv[2][2], bwv[2][2];
#pragma unroll
        for (int bj = 0; bj < 2; ++bj)
#pragma unroll
            for (int n = 0; n < 2; ++n) { csv[bj][n] = *(const f32x4*)(cs + u.pn * BM + bj * HALF + cl + 4 * n); bwv[bj][n] = *(const f32x4*)(bw + u.pn * BM + bj * HALF + cl + 4 * n); }
        const bool zt = (u.pn == 10 || u.pn == 11);
        f32x4 gnv[2] = {(f32x4){1.f, 1.f, 1.f, 1.f}, (f32x4){1.f, 1.f, 1.f, 1.f}};
        if (zt) { gnv[0] = *(const f32x4*)(gn + cl); gnv[1] = *(const f32x4*)(gn + cl + 4); }
#pragma unroll
        for (int ai = 0; ai < 2; ++ai) if (ai < u.nai)
#pragma unroll
            for (int m = 0; m < 4; ++m) {
                const int row = row0 + ai * HALF + m * 16;
                float mean, rstd; row_stats(st, row, mean, rstd);
                const float mr = mean * rstd;
                if (u.pn < 4) {
                    u32x4 w;
#pragma unroll
                    for (int n = 0; n < 2; ++n) {
                        const f32x4 a = acc[ai][0][m][n] * rstd - csv[0][n] * mr + bwv[0][n], g = acc[ai][1][m][n] * rstd - csv[1][n] * mr + bwv[1][n];
                        const float u0 = a[0] * __builtin_amdgcn_rcpf(1.0f + __expf(-g[0])), u1 = a[1] * __builtin_amdgcn_rcpf(1.0f + __expf(-g[1])), u2 = a[2] * __builtin_amdgcn_rcpf(1.0f + __expf(-g[2])), u3 = a[3] * __builtin_amdgcn_rcpf(1.0f + __expf(-g[3]));
                        if (n == 0) { w.x = cvt_pk_bf16(u0, u1); w.y = cvt_pk_bf16(u2, u3); } else { w.z = cvt_pk_bf16(u0, u1); w.w = cvt_pk_bf16(u2, u3); }
                    }
                    *(u32x4*)(H + (size_t)row * 3072 + u.pn * HALF + cl) = w;
                } else
#pragma unroll
                for (int bj = 0; bj < 2; ++bj) {
                    f32x4 v0 = acc[ai][bj][m][0] * rstd - csv[bj][0] * mr + bwv[bj][0], v1 = acc[ai][bj][m][1] * rstd - csv[bj][1] * mr + bwv[bj][1];
                    if (zt) {
#pragma unroll
                        for (int e = 0; e < 4; ++e) { v0[e] = silu_f(v0[e]) * gnv[0][e]; v1[e] = silu_f(v1[e]) * gnv[1][e]; } }
                    if (u.pn < 12) { u32x4 w; w.x = cvt_pk_bf16(v0[0], v0[1]); w.y = cvt_pk_bf16(v0[2], v0[3]); w.z = cvt_pk_bf16(v1[0], v1[1]); w.w = cvt_pk_bf16(v1[2], v1[3]);
                        *(u32x4*)(H + (size_t)row * 3072 + u.pn * BM + bj * HALF + cl) = w; }
                    else if (bj == 0 && cl == 0) { *(f32x4*)(gates + (size_t)row * 8) = v0; *(f32x4*)(gates + (size_t)row * 8 + 4) = v1; }
                }
            }
    }
};

template <int MODE> struct EpiZ {
    static constexpr bool PERM = false, AFTER_DRAIN = false;
    const float* resP; const float* resS; const bf16_t* resB; const float* stp; const float* g; const float* b;
    bf16_t* Zb; float* sto; float scale;
    __device__ __forceinline__ void operator()(const f32x4 (&acc)[2][2][4][2], const Unit& u, int wr, int wc, int fr, int fq) const {
        const int col0 = u.pn * BM + wc * 32 + 4 * fq;
        if (MODE != 1 && u.slab >= 0) {
            float* sb = const_cast<float*>(resP) + (size_t)u.slab * 512 * 1024;
#pragma unroll
            for (int m = 0; m < 4; ++m) { const int row = u.row0 + wr * 64 + m * 16 + fr - 16384;
#pragma unroll
                for (int bj = 0; bj < 2; ++bj) if ((u.bjm >> bj) & 1)
#pragma unroll
                    for (int n = 0; n < 2; ++n) *(f32x4*)(sb + (size_t)row * 1024 + col0 + bj * HALF + n * 16) = acc[0][bj][m][n] * scale; }
            return;
        }
#pragma unroll
        for (int ai = 0; ai < 2; ++ai) if (ai < u.nai)
#pragma unroll
            for (int m = 0; m < 4; ++m) {
                const int rl = ai * HALF + wr * 64 + m * 16 + fr, row = u.row0 + rl;
                float mean = 0.f, rstd = 1.f; if (MODE >= 1) row_stats(stp, row, mean, rstd);
                float s = 0.f, q = 0.f;
#pragma unroll
                for (int bj = 0; bj < 2; ++bj) if ((u.bjm >> bj) & 1)
#pragma unroll
                    for (int n = 0; n < 2; ++n) {
                        const size_t off = (size_t)col0 + bj * HALF + n * 16;
                        f32x4 r;
                        { const u32x2 rb = *(const u32x2*)(resB + (size_t)row * 1024 + off);
                            r[0] = __builtin_bit_cast(float, rb.x << 16); r[1] = __builtin_bit_cast(float, rb.x & 0xffff0000u); r[2] = __builtin_bit_cast(float, rb.y << 16); r[3] = __builtin_bit_cast(float, rb.y & 0xffff0000u); }
                        if (MODE >= 1) { const f32x4 gvv = *(const f32x4*)(g + off), bvv = *(const f32x4*)(b + off); r = (r - mean) * rstd * gvv + bvv; }
                        const f32x4 z = r * DN_ALPHA + acc[ai][bj][m][n] * scale;
                        { u32x2 w; w.x = cvt_pk_bf16(z[0], z[1]); w.y = cvt_pk_bf16(z[2], z[3]); *(u32x2*)(Zb + (size_t)row * 1024 + off) = w; }
                        if (MODE < 2) {
                            s += (z[0] + z[1]) + (z[2] + z[3]); q += (z[0] * z[0] + z[1] * z[1]) + (z[2] * z[2] + z[3] * z[3]); }
                    }
                if (MODE < 2) { s += __shfl_xor(s, 16); s += __shfl_xor(s, 32); q += __shfl_xor(q, 16); q += __shfl_xor(q, 32);
                    if (fq == 0) { unsafeAtomicAdd(sto + 2 * (size_t)row, s); unsafeAtomicAdd(sto + 2 * (size_t)row + 1, q); } }
            }
    }
};

template <class Epi, class Sched, bool ALIGN_EPI = false, bool SP2 = false>
__device__ __forceinline__ void gemm_phase(PG8_LAS unsigned char* lds, const Gemm g, const Sched& S, const Epi& E) {
    int tid_ = threadIdx.x; asm volatile("" : "+v"(tid_));
    const int tid = tid_, wid = __builtin_amdgcn_readfirstlane(tid >> 6), lane = tid & 63, wr = wid >> 2, wc = wid & 3, fr = lane & 15, fq = lane >> 4;
    const int K = g.K, nt = K / BK;
    unsigned voffA[2], voffB[2];
#pragma unroll
    for (int i = 0; i < 2; ++i) { int R, C; stage_rc(tid * 16 + i * 8192, R, C); const int Rb = Epi::PERM ? ((R & ~31) + perm32(R & 31)) : R;
        voffA[i] = (unsigned)(R * K + C) * 2u; voffB[i] = (unsigned)(Rb * K + C) * 2u; }
    const size_t kstep = (size_t)(BK * 2);
    const size_t hstep = (size_t)HALF * K * 2;
    const size_t tstep = 2 * hstep;
    const unsigned ldsw = (unsigned)wid * 1024u;
    const int aoff = lds_byte(wr * 64 + fr, fq * 8), boff = lds_byte(wc * 32 + fr, fq * 8);
#define PG8_SA(b, h) (((b) * 2 + (h)) * HTB)
#define PG8_SB(b, h) ((4 + (b) * 2 + (h)) * HTB)
#define PG8_STAGE(bufoff, gbase, voff) do { _Pragma("unroll") for (int _i = 0; _i < 2; ++_i) \
        __builtin_amdgcn_global_load_lds((const unsigned*)((const char*)(gbase) + (voff)[_i]), (PG8_LAS unsigned*)(lds + (bufoff) + ldsw + _i * 8192), 16, 0, 0); } while (0)
#define PG8_LDA(dst, b, h) do { _Pragma("unroll") for (int m = 0; m < 4; ++m) _Pragma("unroll") for (int k = 0; k < 2; ++k) dst[m][k] = *(const PG8_LAS bf16x8*)(lds + PG8_SA(b, h) + aoff + m * 2048 + k * 1024); } while (0)
#define PG8_LDB(dst, b, h) do { _Pragma("unroll") for (int n = 0; n < 2; ++n) _Pragma("unroll") for (int k = 0; k < 2; ++k) dst[n][k] = *(const PG8_LAS bf16x8*)(lds + PG8_SB(b, h) + boff + n * 2048 + k * 1024); } while (0)
#define PG8_MMA(ai, bj, At, Bt) do { __builtin_amdgcn_s_setprio(1); _Pragma("unroll") for (int m = 0; m < 4; ++m) _Pragma("unroll") for (int n = 0; n < 2; ++n) _Pragma("unroll") for (int k = 0; k < 2; ++k) \
        acc[ai][bj][m][n] = __builtin_amdgcn_mfma_f32_16x16x32_bf16(Bt[n][k], At[m][k], acc[ai][bj][m][n], 0, 0, 0); __builtin_amdgcn_s_setprio(0); } while (0)
#define PG8_WAIT_V(n) asm volatile("s_waitcnt vmcnt(" #n ")" ::: "memory")
#define PG8_WAIT_L(n) asm volatile("s_waitcnt lgkmcnt(" #n ")" ::: "memory")
#define PG8_BAR __builtin_amdgcn_s_barrier()
#define PG8_SCHED __builtin_amdgcn_sched_barrier(0)
    Unit cur, nxt; int ui = 0;
    if (!S.next(0, cur)) return;
    f32x4 acc[2][2][4][2];
#pragma unroll
    for (int a = 0; a < 2; ++a)
#pragma unroll
        for (int b = 0; b < 2; ++b)
#pragma unroll
            for (int m = 0; m < 4; ++m)
#pragma unroll
                for (int n = 0; n < 2; ++n) acc[a][b][m][n] = (f32x4){0.f, 0.f, 0.f, 0.f};
    bf16x8 At[4][2], B0[2][2], B1[2][2];
    const char* cA = (const char*)g.A + (size_t)cur.row0 * K * 2 + (size_t)cur.k0 * kstep; const char* cB = (const char*)g.Bt + (size_t)cur.pn * tstep + (size_t)cur.k0 * kstep;
    S.a_ready(cur);
    if constexpr (SP2) {
        PG8_STAGE(PG8_SB(0, 0), cB, voffB); PG8_STAGE(PG8_SB(0, 1), cB + hstep, voffB); PG8_STAGE(PG8_SA(0, 0), cA, voffA); PG8_STAGE(PG8_SA(0, 1), cA + hstep, voffA);
        if (wr == 1) PG8_BAR;
        PG8_WAIT_V(2); PG8_BAR;
        PG8_STAGE(PG8_SB(1, 0), cB + kstep, voffB); PG8_STAGE(PG8_SA(1, 0), cA + kstep, voffA); PG8_STAGE(PG8_SB(1, 1), cB + hstep + kstep, voffB);
        PG8_WAIT_V(6); PG8_BAR;
    } else {
        PG8_STAGE(PG8_SB(0, 0), cB, voffB); PG8_STAGE(PG8_SA(0, 0), cA, voffA); PG8_STAGE(PG8_SB(0, 1), cB + hstep, voffB); PG8_STAGE(PG8_SA(0, 1), cA + hstep, voffA);
        if (wr == 1) PG8_BAR;
        PG8_WAIT_V(4); PG8_BAR;
        PG8_STAGE(PG8_SB(1, 0), cB + kstep, voffB); PG8_STAGE(PG8_SA(1, 0), cA + kstep, voffA); PG8_STAGE(PG8_SB(1, 1), cB + hstep + kstep, voffB);
        PG8_WAIT_V(6); PG8_BAR;
    }
    for (;;) {
        const bool has_next = S.next(ui + 1, nxt);
        const char* nA = has_next ? (const char*)g.A + (size_t)nxt.row0 * K * 2 + (size_t)nxt.k0 * kstep : cA; const char* nB = has_next ? (const char*)g.Bt + (size_t)nxt.pn * tstep + (size_t)nxt.k0 * kstep : cB;
        const int unt = cur.ntk ? cur.ntk : nt;
        const bool full = (cur.nai == 2);
        for (int t = 0; t < unt; t += 2) {
            const bool last = (t == unt - 2);
            const char* a1 = cA + (size_t)(t + 1) * kstep;
            const char* a2 = last ? nA : cA + (size_t)(t + 2) * kstep; const char* b2 = last ? nB : cB + (size_t)(t + 2) * kstep;
            const char* a3 = a2 + kstep; const char* b3 = b2 + kstep;
            if (last && has_next) S.a_ready(nxt);
            if constexpr (SP2) {
            PG8_LDB(B0, 0, 0); PG8_LDB(B1, 0, 1); PG8_SCHED; PG8_LDA(At, 0, 0); PG8_STAGE(PG8_SA(1, 1), a1 + hstep, voffA);
            PG8_WAIT_V(8); PG8_WAIT_L(0); PG8_BAR; if (cur.bjm & 1) PG8_MMA(0, 0, At, B0); if (cur.bjm & 2) PG8_MMA(0, 1, At, B1); PG8_BAR; PG8_SCHED;
            PG8_LDA(At, 0, 1); PG8_STAGE(PG8_SB(0, 0), b2, voffB); PG8_STAGE(PG8_SB(0, 1), b2 + hstep, voffB); PG8_STAGE(PG8_SA(0, 0), a2, voffA);
            PG8_WAIT_V(8); PG8_WAIT_L(0); PG8_BAR; if (full) { PG8_MMA(1, 0, At, B0); PG8_MMA(1, 1, At, B1); } PG8_BAR; PG8_SCHED;
            PG8_LDB(B0, 1, 0); PG8_LDB(B1, 1, 1); PG8_SCHED; PG8_LDA(At, 1, 0); PG8_STAGE(PG8_SA(0, 1), a2 + hstep, voffA);
            PG8_WAIT_V(8); PG8_WAIT_L(0); PG8_BAR; if (cur.bjm & 1) PG8_MMA(0, 0, At, B0); if (cur.bjm & 2) PG8_MMA(0, 1, At, B1); PG8_BAR; PG8_SCHED;
            PG8_LDA(At, 1, 1); PG8_STAGE(PG8_SB(1, 0), b3, voffB); PG8_STAGE(PG8_SB(1, 1), b3 + hstep, voffB); PG8_STAGE(PG8_SA(1, 0), a3, voffA);
            PG8_WAIT_V(8); PG8_WAIT_L(0); PG8_BAR; if (full) { PG8_MMA(1, 0, At, B0); PG8_MMA(1, 1, At, B1); } PG8_BAR; PG8_SCHED;
            } else {
            PG8_LDB(B0, 0, 0); PG8_SCHED; PG8_LDA(At, 0, 0); PG8_STAGE(PG8_SA(1, 1), a1 + hstep, voffA);
            PG8_WAIT_L(8); PG8_BAR; PG8_WAIT_L(0); PG8_MMA(0, 0, At, B0); PG8_BAR; PG8_SCHED;
            PG8_LDB(B1, 0, 1); PG8_STAGE(PG8_SB(0, 0), b2, voffB);
            PG8_BAR; PG8_WAIT_L(0); PG8_MMA(0, 1, At, B1); PG8_BAR;
            PG8_LDA(At, 0, 1); PG8_STAGE(PG8_SA(0, 0), a2, voffA);
            PG8_BAR; PG8_WAIT_L(0); PG8_MMA(1, 0, At, B0); PG8_BAR; PG8_SCHED;
            PG8_STAGE(PG8_SB(0, 1), b2 + hstep, voffB);
            PG8_WAIT_V(6); PG8_BAR; PG8_MMA(1, 1, At, B1); PG8_BAR;
            PG8_LDB(B0, 1, 0); PG8_SCHED; PG8_LDA(At, 1, 0); PG8_STAGE(PG8_SA(0, 1), a2 + hstep, voffA);
            PG8_WAIT_L(8); PG8_BAR; PG8_WAIT_L(0); PG8_MMA(0, 0, At, B0); PG8_BAR; PG8_SCHED;
            PG8_LDB(B1, 1, 1); PG8_STAGE(PG8_SB(1, 0), b3, voffB);
            PG8_BAR; PG8_WAIT_L(0); PG8_MMA(0, 1, At, B1); PG8_BAR;
            PG8_LDA(At, 1, 1); PG8_STAGE(PG8_SA(1, 0), a3, voffA);
            PG8_BAR; PG8_WAIT_L(0); PG8_MMA(1, 0, At, B0); PG8_BAR; PG8_SCHED;
            PG8_STAGE(PG8_SB(1, 1), b3 + hstep, voffB);
            PG8_WAIT_V(6); PG8_BAR; PG8_MMA(1, 1, At, B1); PG8_BAR;
            }
        }
        if constexpr (ALIGN_EPI) { if (wr == 0) PG8_BAR; }
        if constexpr (!Epi::AFTER_DRAIN) { E(acc, cur, wr, wc, fr, fq); S.done(cur); }
        if (!has_next) break;
#pragma unroll
        for (int a = 0; a < 2; ++a)
#pragma unroll
            for (int b = 0; b < 2; ++b)
#pragma unroll
                for (int m = 0; m < 4; ++m)
#pragma unroll
                    for (int n = 0; n < 2; ++n) acc[a][b][m][n] = (f32x4){0.f, 0.f, 0.f, 0.f};
        cur = nxt; cA = nA; cB = nB; ++ui;
        if constexpr (ALIGN_EPI) { if (wr == 1) PG8_BAR; }
    }
    PG8_WAIT_V(0);
    if constexpr (!ALIGN_EPI) { if (wr == 0) PG8_BAR; }
    PG8_BAR;
    if constexpr (Epi::AFTER_DRAIN) { E.fused(acc, cur, wr, wc, fr, fq, lds, wid, lane); S.done(cur); }
#undef PG8_SA
#undef PG8_SB
#undef PG8_STAGE
#undef PG8_LDA
#undef PG8_LDB
#undef PG8_MMA
#undef PG8_WAIT_V
#undef PG8_WAIT_L
#undef PG8_BAR
#undef PG8_SCHED
}
}
constexpr int NWAVES = 8;
constexpr int DM = 1024, NBP = 8, TP = 2048, NBS = 128, TS = 4;
constexpr int MP = NBP * TP, MS = NBS * TS, MTOT = MP + MS;
constexpr int DFF = 2816, NUP = 2 * DFF, CCH = 512, CWID = 31, NH = 4, DKH = 128, QKVD = 1536, HPITCH = 3072, NIN = 3328, PROJ = 3080;
constexpr float LN_EPS = 1e-5f, RMS_EPS = 1e-6f;
constexpr int NCH = NBP * (TP / 64) * NH;

constexpr size_t MiB = 1u << 20;
constexpr size_t WS_CTL = 0, CTL_ZERO_BYTES = MiB / 2;
constexpr size_t WS_ST1 = 65536, WS_ST2 = WS_ST1 + (size_t)MTOT * 8, WS_CSIN = 393216, WS_BWIN = 409600, WS_CSUP2 = 425984, WS_BWUP2 = 450560;
static_assert(WS_ST2 + (size_t)MTOT * 8 <= WS_CSIN && WS_BWUP2 + NUP * 4 <= CTL_ZERO_BYTES, "ctl map");
constexpr size_t WS_WUP1 = 2 * MiB, WS_WDN1 = 13 * MiB, WS_WIN = 18 * MiB + MiB / 2, WS_WOUT = 25 * MiB, WS_WUP2 = 27 * MiB, WS_WDN2 = 38 * MiB;
constexpr size_t WS_H = 44 * MiB, WS_XB = 44 * MiB, WS_HID = 77 * MiB, WS_Z1B = 168 * MiB, WS_PREP = 143 * MiB, WS_MIX = 215 * MiB, WS_GATES = 248 * MiB, WS_EGL = 249 * MiB;
constexpr size_t WS_SLAB1 = 168 * MiB, WS_Z2 = 44 * MiB, WS_SLAB = 77 * MiB, WS_Z2B = 110 * MiB, WS_HID2 = 143 * MiB, WS_END = 250 * MiB;
constexpr size_t PREP_STRIDE = 73728, PREP_W = 0, PREP_QG = 16384, PREP_KDT = 32768, PREP_QK = 49152, PREP_UT = 57344;
static_assert(WS_HID + (size_t)MTOT * DFF * 2 <= WS_Z1B && WS_PREP + (size_t)NCH * PREP_STRIDE <= WS_MIX && WS_HID2 + (size_t)MTOT * DFF * 2 <= WS_END, "ws map");
constexpr int CW_TMO = 0, CW_CODE = 1, CW_BAR = 4096, CW_FLAG = 122880, CW_QCTR = 124928, CW_XCC = 125440, CW_VIOL = 125952;
static_assert((CW_VIOL + 64) * 4 <= (int)CTL_ZERO_BYTES && (size_t)CW_FLAG * 4 >= WS_BWUP2 + (size_t)NUP * 4, "ctl words");
constexpr size_t OUT_Y = 0, OUT_CONVP = (size_t)MTOT * DM, OUT_QKVP = OUT_CONVP + (size_t)NBP * 30 * CCH, OUT_RECP = OUT_QKVP + (size_t)NBP * 3 * QKVD,
                 OUT_CONVS = OUT_RECP + (size_t)NBP * NH * 128 * 128, OUT_QKVS = OUT_CONVS + (size_t)NBS * 30 * CCH, OUT_RECS = OUT_QKVS + (size_t)NBS * 3 * QKVD,
                 OUT_TOTAL = OUT_RECS + (size_t)NBS * NH * 128 * 128;
static_assert(OUT_TOTAL == 28930048, "output size");

constexpr int RING_OFF = 0, RING_BYTES = 131072;
constexpr int LDS_BYTES = 155648;
constexpr int MISC_OFF = LDS_BYTES - 256;

#define GAS __attribute__((address_space(1)))
#define LAS __attribute__((address_space(3)))
typedef unsigned short bf16;
typedef unsigned v4u __attribute__((ext_vector_type(4)));
typedef unsigned v2u __attribute__((ext_vector_type(2)));
typedef float f32x4 __attribute__((ext_vector_type(4)));
typedef float f32x2 __attribute__((ext_vector_type(2)));
typedef short bf16x8 __attribute__((ext_vector_type(8)));
typedef GAS unsigned gu32;
#define RLX_AGENT __ATOMIC_RELAXED, __HIP_MEMORY_SCOPE_AGENT
#define LDS_WAIT() asm volatile("s_waitcnt lgkmcnt(0)" ::: "memory")
#define VM_WAIT() asm volatile("s_waitcnt vmcnt(0)" ::: "memory")
#define LBAR() do { asm volatile("s_waitcnt lgkmcnt(0)" ::: "memory"); __builtin_amdgcn_s_barrier(); asm volatile("" ::: "memory"); } while (0)
__device__ __forceinline__ unsigned f2bf(float f) { unsigned u = __builtin_bit_cast(unsigned, f); return (u + 0x7fffu + ((u >> 16) & 1u)) >> 16; }
typedef __bf16 bf16x2_t __attribute__((ext_vector_type(2)));
__device__ __forceinline__ unsigned pk2(float lo, float hi) { const f32x2 v = {lo, hi}; return __builtin_bit_cast(unsigned, __builtin_convertvector(v, bf16x2_t)); }
__device__ __forceinline__ float bf2f(unsigned h) { return __builtin_bit_cast(float, h << 16); }
__device__ __forceinline__ void unpack8(const v4u w, float* o) {
    o[0] = bf2f(w.x & 0xffffu); o[1] = __builtin_bit_cast(float, w.x & 0xffff0000u); o[2] = bf2f(w.y & 0xffffu); o[3] = __builtin_bit_cast(float, w.y & 0xffff0000u);
    o[4] = bf2f(w.z & 0xffffu); o[5] = __builtin_bit_cast(float, w.z & 0xffff0000u); o[6] = bf2f(w.w & 0xffffu); o[7] = __builtin_bit_cast(float, w.w & 0xffff0000u);
}
__device__ __forceinline__ v4u pack8(const float* v) { v4u w; w.x = pk2(v[0], v[1]); w.y = pk2(v[2], v[3]); w.z = pk2(v[4], v[5]); w.w = pk2(v[6], v[7]); return w; }
__device__ __forceinline__ float sigmoid_f(float x) { return __builtin_amdgcn_rcpf(1.0f + __expf(-x)); }
__device__ __forceinline__ float siluf(float x) { return x * __builtin_amdgcn_rcpf(1.0f + __expf(-x)); }
__device__ __forceinline__ float softplus_f(float x) { return fmaxf(x, 0.f) + log1pf(expf(-fabsf(x))); }
__device__ __forceinline__ float wave_sum(float v) {
#pragma unroll
    for (int o = 1; o < 64; o <<= 1) v += __shfl_xor(v, o);
    return v;
}
__device__ __forceinline__ bf16x8 ldfrag(const LAS bf16* base, int ld, int r0, int k0, int lane) { return *(const LAS bf16x8*)(base + (r0 + (lane & 15)) * ld + k0 + 8 * (lane >> 4)); }
#define MFMA16(a, b, c) __builtin_amdgcn_mfma_f32_16x16x32_bf16((a), (b), (c), 0, 0, 0)

#define XB_TMO      128
#define XB_XCNT(j)  (256  + 64 * (j))
#define XB_XSUB(j)  (1280 + 64 * (j))
#define XB_XGEN(j)  (2304 + 64 * (j))
#define XB_TOP      3328
#define XB_TOPGEN   3392
#define XCD_BAR_WORDS 3456
#define XB_SPIN_CAP (1u << 18)

__device__ __forceinline__ unsigned xb_ld(unsigned* p)              { return __hip_atomic_load(p, __ATOMIC_RELAXED, __HIP_MEMORY_SCOPE_AGENT); }
__device__ __forceinline__ unsigned xb_add(unsigned* p, unsigned v) { return __hip_atomic_fetch_add(p, v, __ATOMIC_RELAXED, __HIP_MEMORY_SCOPE_AGENT); }
__device__ __forceinline__ unsigned xb_xcc_id() { return (unsigned)__builtin_amdgcn_s_getreg((3 << 11) | 20) & 0xFu; }
#define XB_SPIN(cond, bar) do { unsigned _sp = 0; while (cond) { __builtin_amdgcn_s_sleep(1); \
    if ((++_sp & 255u) == 0u) { if (xb_ld(&(bar)[XB_TMO])) break; if (_sp > XB_SPIN_CAP) { atomicAdd(&(bar)[XB_TMO], 1u); break; } } } } while (0)

struct XcdBarrier {
    unsigned* bar; unsigned x;
    volatile LAS unsigned* st;
};

__device__ __forceinline__ XcdBarrier xcd_barrier_post(unsigned* bar, volatile LAS unsigned* st) {
    XcdBarrier b; b.bar = bar; b.x = xb_xcc_id(); b.st = st;
    if (threadIdx.x == 0) (void)xb_add(&bar[XB_XCNT(b.x)], 1u);
    return b;
}
__device__ __forceinline__ void xcd_barrier_complete(unsigned* bar, unsigned x, unsigned& nloc, unsigned& nx) {
    const unsigned G = gridDim.x * gridDim.y * gridDim.z;
    unsigned sum, cnt, mine, sp = 0u;
    for (;;) {
        sum = 0u; cnt = 0u; mine = 0u;
#pragma unroll
        for (unsigned j = 0; j < 16; ++j) { const unsigned c = xb_ld(&bar[XB_XCNT(j)]); sum += c; cnt += (c > 0u) ? 1u : 0u; mine = (j == x) ? c : mine; }
        if (sum == G) break;
        __builtin_amdgcn_s_sleep(1);
        if ((++sp & 255u) == 0u) { if (xb_ld(&bar[XB_TMO])) break; if (sp > XB_SPIN_CAP) { atomicAdd(&bar[XB_TMO], 1u); break; } }
    }
    nloc = mine > 0u ? mine : 1u; nx = cnt > 0u ? cnt : 1u;
}

__device__ __forceinline__ void xcd_barrier(const XcdBarrier& b) {
    asm volatile("s_waitcnt vmcnt(0)" ::: "memory");
    __syncthreads();
    if (threadIdx.x == 0) {
        unsigned* bar = b.bar; const unsigned bx_ = (unsigned)__builtin_amdgcn_readfirstlane((int)xb_xcc_id());
        __builtin_amdgcn_s_waitcnt(0);
        unsigned nloc = b.st[0], nx = b.st[1];
        if (nloc == 0u) { xcd_barrier_complete(bar, bx_, nloc, nx); b.st[0] = nloc; b.st[1] = nx; }
        const unsigned old = xb_add(&bar[XB_XSUB(bx_)], 1u);
        const unsigned gen = old / nloc;
        if (old + 1u == (gen + 1u) * nloc) {
            __builtin_amdgcn_fence(__ATOMIC_RELEASE, "agent");
            asm volatile("s_waitcnt vmcnt(0)" ::: "memory");
            const unsigned og = xb_add(&bar[XB_TOP], 1u);
            const unsigned tg = og / nx;
            if (og + 1u == (tg + 1u) * nx) xb_add(&bar[XB_TOPGEN], 1u);
            else XB_SPIN(xb_ld(&bar[XB_TOPGEN]) == tg, bar);
            __builtin_amdgcn_fence(__ATOMIC_ACQUIRE, "agent");
            xb_add(&bar[XB_XGEN(bx_)], 1u);
            asm volatile("s_waitcnt vmcnt(0)" ::: "memory");
        } else {
            XB_SPIN(xb_ld(&bar[XB_XGEN(bx_)]) == gen, bar);
            __builtin_amdgcn_fence(__ATOMIC_ACQUIRE, "agent");
            asm volatile("s_waitcnt vmcnt(0)" ::: "memory");
        }
    }
    __syncthreads();
}
#define CAS __attribute__((address_space(4)))
__device__ __forceinline__ const float* inp(int k) { const CAS char* p = (const CAS char*)__builtin_amdgcn_kernarg_segment_ptr(); asm volatile("" : "+s"(p)); return *(const float* const CAS*)(p + 8 * k); }
struct Frame {
    LAS unsigned char* lds;
    volatile LAS unsigned* MISC;
    gu32* ctl;
    int tid, lane, wave;
    int vcu, G;
    unsigned char* ws; float* out;
};

__device__ __forceinline__ void p0_item(const float* W, int K, int Nsrc, int src0, int src1, bf16* WT, int dst_row0, int kb, const float* gv, const float* bv, float* cs, float* bw, LAS float* scr, int lane) {
    const int k0 = 64 * kb, kk = lane >> 4, n4 = lane & 15;
    const int sc = (n4 < 8 ? src0 : src1 - 32) + 4 * n4;
    const bool ok = sc + 3 < Nsrc;
    f32x4 v[16];
#pragma unroll
    for (int i = 0; i < 16; ++i) v[i] = ok ? __builtin_nontemporal_load((const f32x4*)(W + (size_t)(k0 + 4 * i + kk) * Nsrc + sc)) : (f32x4){0.f, 0.f, 0.f, 0.f};
#pragma unroll
    for (int i = 0; i < 16; ++i) { const int k = 4 * i + kk; *(LAS f32x4*)(scr + k * 64 + ((n4 ^ ((k >> 3) & 7)) << 2)) = v[i]; }
    LDS_WAIT(); asm volatile("" ::: "memory");
    const int c = lane & 7, nl = lane >> 3;
    float g8[8], b8[8];
#pragma unroll
    for (int i = 0; i < 8; ++i) { g8[i] = gv ? gv[k0 + 8 * c + i] : 1.f; b8[i] = (cs && bv) ? bv[k0 + 8 * c + i] : 0.f; }
#pragma unroll
    for (int j = 0; j < 8; ++j) {
        const int n = 8 * j + nl;
        float w[8], wg[8];
#pragma unroll
        for (int i = 0; i < 8; ++i) { w[i] = scr[(8 * c + i) * 64 + ((((n >> 2) ^ c) << 2) | (n & 3))]; wg[i] = w[i] * g8[i]; }
        const v4u o = pack8(wg);
        *(GAS v4u*)(WT + (size_t)(dst_row0 + n) * K + k0 + 8 * c) = o;
        if (cs) {
            float r[8]; unpack8(o, r);
            float a = 0.f, bsum = 0.f;
#pragma unroll
            for (int i = 0; i < 8; ++i) { a += r[i]; bsum += b8[i] * w[i]; }
            a += __shfl_xor(a, 1); a += __shfl_xor(a, 2); a += __shfl_xor(a, 4);
            bsum += __shfl_xor(bsum, 1); bsum += __shfl_xor(bsum, 2); bsum += __shfl_xor(bsum, 4);
            if (c == 0) { unsafeAtomicAdd(cs + dst_row0 + n, a); unsafeAtomicAdd(bw + dst_row0 + n, bsum); }
        }
    }
    LDS_WAIT(); asm volatile("" ::: "memory");
}
__device__ __forceinline__ int up_src_col(int dst_row0) { const int pn = dst_row0 >> 8, j0 = dst_row0 & 255; return j0 < 128 ? 128 * pn + j0 : DFF + 128 * pn + (j0 - 128); }
__device__ __forceinline__ int in_src_col(int dst_row0) { if (dst_row0 >= 1024) return dst_row0; const int pn = dst_row0 >> 8, j0 = dst_row0 & 255; return j0 < 128 ? 128 * pn + j0 : 512 + 128 * pn + (j0 - 128); }
template <int SET> __device__ __forceinline__ void p0_weights(Frame& F, int gw, int NGW) {
    LAS float* scr = (LAS float*)(F.lds + RING_OFF + F.wave * 16384);
    constexpr int I_UP = (DM / 64) * (NUP / 64), I_DN = (DFF / 64) * (DM / 64), I_IN = (DM / 64) * (NIN / 64), I_OUT = (DM / 64) * (DM / 64);
    constexpr int NITEMS = SET == 0 ? I_UP : (SET == 2 ? I_DN + I_IN + I_OUT : I_UP + I_DN);
    unsigned char* ws = F.ws;
    for (int it = gw; it < NITEMS; it += NGW) {
        int r = it;
        if (SET == 0) {
            const int nb = r % (NUP / 64), kb = r / (NUP / 64); p0_item(inp(5), DM, NUP, up_src_col(64 * nb), up_src_col(64 * nb + 32), (bf16*)(ws + WS_WUP1), 64 * nb, kb, nullptr, nullptr, nullptr, nullptr, scr, F.lane);
        } else if (SET == 2) {
            if (r < I_DN) { const int nb = r % (DM / 64), kb = r / (DM / 64); p0_item(inp(6), DFF, DM, 64 * nb, 64 * nb + 32, (bf16*)(ws + WS_WDN1), 64 * nb, kb, nullptr, nullptr, nullptr, nullptr, scr, F.lane); continue; } r -= I_DN;
            if (r < I_IN) { const int nb = r % (NIN / 64), kb = r / (NIN / 64); p0_item(inp(9), DM, PROJ, in_src_col(64 * nb), in_src_col(64 * nb + 32), (bf16*)(ws + WS_WIN), 64 * nb, kb, inp(7), inp(8), (float*)(ws + WS_CSIN), (float*)(ws + WS_BWIN), scr, F.lane); continue; } r -= I_IN;
            { const int nb = r % (DM / 64), kb = r / (DM / 64); p0_item(inp(18), DM, DM, 64 * nb, 64 * nb + 32, (bf16*)(ws + WS_WOUT), 64 * nb, kb, nullptr, nullptr, nullptr, nullptr, scr, F.lane); }
        } else {
            if (r < I_UP) { const int nb = r % (NUP / 64), kb = r / (NUP / 64); p0_item(inp(21), DM, NUP, up_src_col(64 * nb), up_src_col(64 * nb + 32), (bf16*)(ws + WS_WUP2), 64 * nb, kb, inp(19), inp(20), (float*)(ws + WS_CSUP2), (float*)(ws + WS_BWUP2), scr, F.lane); continue; } r -= I_UP;
            { const int nb = r % (DM / 64), kb = r / (DM / 64); p0_item(inp(22), DFF, DM, 64 * nb, 64 * nb + 32, (bf16*)(ws + WS_WDN2), 64 * nb, kb, nullptr, nullptr, nullptr, nullptr, scr, F.lane); }
        }
    }
}
__device__ __forceinline__ void p0_prologue(Frame& F) {
    const int gw = F.vcu * NWAVES + F.wave, NGW = F.G * NWAVES;
    unsigned char* ws = F.ws;
    p0_weights<0>(F, gw, NGW);
    bf16* xb = (bf16*)(ws + WS_XB);
    for (int m0 = 2 * gw; m0 < MTOT; m0 += 2 * NGW) {
        f32x4 v[2][4];
#pragma unroll
        for (int r2 = 0; r2 < 2; ++r2) { const int m = m0 + r2; const float* xr = (m < MP) ? inp(0) + (size_t)m * DM : inp(1) + (size_t)(m - MP) * DM;
            const GAS f32x4* x4 = (const GAS f32x4*)xr + F.lane;
#pragma unroll
            for (int j = 0; j < 4; ++j) v[r2][j] = __builtin_nontemporal_load((const f32x4*)x4 + 64 * j); }
#pragma unroll
        for (int r2 = 0; r2 < 2; ++r2) { GAS v2u* o8 = (GAS v2u*)(xb + (size_t)(m0 + r2) * DM) + F.lane;
#pragma unroll
            for (int j = 0; j < 4; ++j) { v2u w; w.x = pk2(v[r2][j].x, v[r2][j].y); w.y = pk2(v[r2][j].z, v[r2][j].w); o8[64 * j] = w; } }
    }
}

__host__ __device__ constexpr int swap23(int k) { return (k & ~12) | ((k & 4) << 1) | ((k & 8) >> 1); }
__host__ __device__ constexpr int ut_tok(int P) { return (P & ~31) | (P & 3) | (((P >> 4) & 1) << 2) | (((P >> 2) & 3) << 3); }
constexpr int AMP = 68;
constexpr int P4_QN = 0, P4_KN = 17408, P4_KB = 34816, P4_RHS = 52224, P4_AM = 117760, P4_GC = 135168, P4_CW = 145152;
__device__ __forceinline__ int p4_flag_index(int ch) { return (((ch >> 7) * 4 + (ch & 3)) << 5) + ((ch >> 2) & 31); }
__device__ __forceinline__ void p4_run(Frame& F, const int ch0, const int stride, const int nit, const bool publish) {
    LAS bf16* Qn = (LAS bf16*)(F.lds + P4_QN); LAS bf16* Kn = (LAS bf16*)(F.lds + P4_KN); LAS bf16* KB = (LAS bf16*)(F.lds + P4_KB);
    LAS float* RHS = (LAS float*)(F.lds + P4_RHS); LAS float* AM = (LAS float*)(F.lds + P4_AM); LAS float* GC = (LAS float*)(F.lds + P4_GC); LAS float* BT = GC + 64; LAS float* ED = GC + 128;
    LAS bf16* AB = (LAS bf16*)(F.lds + P4_GC + 768);
    LAS bf16* XT = (LAS bf16*)(F.lds + 0);
    LAS float* CW = (LAS float*)(F.lds + P4_CW);
    const bf16* H = (const bf16*)(F.ws + WS_H); const float* gates = (const float*)(F.ws + WS_GATES);
    if (nit <= 0) return;
    const bool same_head = (stride & 3) == 0;
    v4u nx[3][4]; float nvm[4]; float gbl = 0.f, gal = 0.f;
#define P4_LOADROWS(CH, PASS) do { const int hh_ = (CH) & 3, n_ = ((CH) >> 2) & 31, b_ = (CH) >> 7; const int t_ = (ftid >> 4) + 32 * (PASS), c0_ = (ftid & 15) * 8, tt_ = n_ * 64 + t_; \
        _Pragma("unroll") for (int i = 0; i < 4; ++i) { const int r = tt_ - 3 + i; const int rc = r < 0 ? 0 : r; nvm[i] = r < 0 ? 0.f : 1.f;     \
            _Pragma("unroll") for (int X = 0; X < 3; ++X) nx[X][i] = *(const v4u*)(H + ((size_t)b_ * TP + rc) * HPITCH + 1024 + X * 512 + hh_ * 128 + c0_); } } while (0)
#define P4_LOADGATES(CH) do { const int hh_ = (CH) & 3, n_ = ((CH) >> 2) & 31, b_ = (CH) >> 7; if (wv == 0) { const size_t m_ = (size_t)b_ * TP + n_ * 64 + ftid; gbl = gates[m_ * 8 + hh_]; gal = gates[m_ * 8 + 4 + hh_]; } } while (0)
#define P4_STAGECW(HH) do { const int cwi = ftid / 96, cwr = ftid % 96; \
        if (wv < 6) *(LAS f32x4*)(CW + cwi * 384 + (cwr >> 5) * 128 + 4 * (cwr & 31)) = *(const f32x4*)(inp(14) + (size_t)cwi * QKVD + (cwr >> 5) * 512 + (HH) * 128 + 4 * (cwr & 31)); } while (0)
    { int tq_ = threadIdx.x; asm volatile("" : "+v"(tq_)); const int ftid = tq_, wv = __builtin_amdgcn_readfirstlane(tq_ >> 6);
      P4_LOADROWS(ch0, 0); P4_LOADGATES(ch0);
      if (same_head) { P4_STAGECW(ch0 & 3); LBAR(); } }
#pragma unroll 1
  for (int it = 0; it < nit; ++it) {
    int ch_ = ch0 + it * stride, chn_ = (it + 1 < nit) ? ch_ + stride : ch_;
    asm volatile("" : "+s"(ch_), "+s"(chn_));
    const int ch = ch_, chn = chn_;
    const int hh = ch & 3, n = (ch >> 2) & 31, b = ch >> 7;
    unsigned char* pb = F.ws + WS_PREP + (size_t)ch * PREP_STRIDE;
    bf16* Wg = (bf16*)(pb + PREP_W); bf16* QGg = (bf16*)(pb + PREP_QG); bf16* KDTg = (bf16*)(pb + PREP_KDT); bf16* QKg = (bf16*)(pb + PREP_QK); bf16* UTg = (bf16*)(pb + PREP_UT);
    int tq_ = threadIdx.x; asm volatile("" : "+v"(tq_));
    const int lane = tq_ & 63, ftid = tq_, wv = __builtin_amdgcn_readfirstlane(tq_ >> 6);
    if (!same_head) { P4_STAGECW(hh); LBAR(); }
    if (wv == 0) {
        const int t = ftid;
        BT[t] = sigmoid_f(gbl);
        float v = -expf(inp(15)[hh]) * softplus_f(gal + inp(16)[hh]);
#pragma unroll
        for (int o = 1; o < 64; o <<= 1) { const float u = __shfl_up(v, o); if (lane >= o) v += u; }
        GC[t] = v;
        ED[t] = expf(__shfl(v, 63) - v);
    }
    float gl = 0.f;
#pragma unroll 1
    for (int pass = 0; pass < 2; ++pass) {
        int tid_ = ftid; asm volatile("" : "+v"(tid_));
        const int tid = tid_, t = (tid >> 4) + 32 * pass, cg = tid & 15, c0 = cg * 8;
        const int tt = n * 64 + t;
        float xq[3][8];
        v4u rawp[3][4]; float vm[4];
#pragma unroll
        for (int i = 0; i < 4; ++i) { vm[i] = nvm[i];
#pragma unroll
            for (int X = 0; X < 3; ++X) rawp[X][i] = nx[X][i]; }
        asm volatile("" : "+v"(rawp[0][0].x), "+v"(rawp[1][0].x), "+v"(rawp[2][0].x));
        asm volatile("" : "+v"(rawp[0][3].w), "+v"(rawp[1][3].w), "+v"(rawp[2][3].w));
        if (pass == 0) P4_LOADROWS(ch, 1);
        else if (publish) VM_WAIT();
        if (n == 0) {
#pragma unroll
            for (int i = 0; i < 4; ++i)
#pragma unroll
                for (int X = 0; X < 3; ++X) if (vm[i] == 0.f) rawp[X][i] = (v4u){0u, 0u, 0u, 0u};
        }
#pragma unroll
        for (int X = 0; X < 3; ++X) {
            const int col = X * 512 + hh * 128 + c0;
            f32x4 wv[4][2];
#pragma unroll
            for (int i = 0; i < 4; ++i) { const LAS f32x4* wp = (const LAS f32x4*)(CW + i * 384 + X * 128 + c0); wv[i][0] = wp[0]; wv[i][1] = wp[1]; }
            float acc[8];
#pragma unroll
            for (int c = 0; c < 8; ++c) acc[c] = 0.f;
#pragma unroll
            for (int i = 0; i < 4; ++i) {
                float raw[8]; unpack8(rawp[X][i], raw);
#pragma unroll
                for (int e = 0; e < 4; ++e) { acc[e] += wv[i][0][e] * raw[e]; acc[4 + e] += wv[i][1][e] * raw[4 + e]; }
            }
#pragma unroll
            for (int c = 0; c < 8; ++c) xq[X][c] = siluf(acc[c]);
        }
        float sq = 0.f, sk = 0.f;
#pragma unroll
        for (int c = 0; c < 8; ++c) { sq += xq[0][c] * xq[0][c]; sk += xq[1][c] * xq[1][c]; }
        sq += __shfl_xor(sq, 1); sq += __shfl_xor(sq, 2); sq += __shfl_xor(sq, 4); sq += __shfl_xor(sq, 8);
        sk += __shfl_xor(sk, 1); sk += __shfl_xor(sk, 2); sk += __shfl_xor(sk, 4); sk += __shfl_xor(sk, 8);
        const float rq = rsqrtf(sq + RMS_EPS) * 0.08838834764831845f, rk = rsqrtf(sk + RMS_EPS);
        if (pass == 0) { LBAR(); gl = GC[63]; }
        const float beta = BT[t], gc = GC[t], eg = expf(gc);
        float q[8], k[8], kb[8], qg[8];
#pragma unroll
        for (int c = 0; c < 8; ++c) { q[c] = xq[0][c] * rq; k[c] = xq[1][c] * rk; kb[c] = k[c] * beta; qg[c] = q[c] * eg; }
        *(LAS v4u*)(Qn + t * 136 + c0) = pack8(q); *(LAS v4u*)(Kn + t * 136 + c0) = pack8(k); *(LAS v4u*)(KB + t * 136 + c0) = pack8(kb);
        { v2u lo, hi; lo.x = pk2(qg[0], qg[1]); lo.y = pk2(qg[2], qg[3]); hi.x = pk2(qg[4], qg[5]); hi.y = pk2(qg[6], qg[7]);
          bf16* qp = QGg + t * 128 + (c0 & ~15) + 4 * (cg & 1); *(v2u*)qp = lo; *(v2u*)(qp + 8) = hi; }
        { LAS f32x4* rp = (LAS f32x4*)(RHS + t * 256 + c0);
          rp[0] = (f32x4){xq[2][0] * beta, xq[2][1] * beta, xq[2][2] * beta, xq[2][3] * beta}; rp[1] = (f32x4){xq[2][4] * beta, xq[2][5] * beta, xq[2][6] * beta, xq[2][7] * beta};
          rp[32] = (f32x4){kb[0] * eg, kb[1] * eg, kb[2] * eg, kb[3] * eg}; rp[33] = (f32x4){kb[4] * eg, kb[5] * eg, kb[6] * eg, kb[7] * eg}; }
        if (n == 31 && t == 63) {
            for (int X = 0; X < 3; ++X)
                for (int j = 0; j < 3; ++j) { float* o = F.out + OUT_QKVP + ((size_t)b * 3 + j) * QKVD + X * 512 + hh * 128 + c0;
                    const bf16* p = H + ((size_t)b * TP + (TP - 3 + j)) * HPITCH + 1024 + X * 512 + hh * 128 + c0;
                    for (int c = 0; c < 8; ++c) o[c] = bf2f(p[c]); }
        }
    }
    if (ftid == 0) ((float*)(F.ws + WS_EGL))[ch * 32] = expf(gl);
    LBAR();
    if (publish && it > 0 && ftid == 511) __hip_atomic_store((unsigned*)(F.ctl + CW_FLAG) + p4_flag_index(ch - stride), 1u, RLX_AGENT);
    {
        const int dk = ftid & 127, pg = ftid >> 7;
#pragma unroll
        for (int g2 = 0; g2 < 2; ++g2) {
            const int p0 = 8 * (2 * pg + g2); float kv[8];
#pragma unroll
            for (int e = 0; e < 8; ++e) { const int tok = swap23(p0 + e); kv[e] = bf2f(Kn[tok * 136 + dk]) * ED[tok]; }
            *(v4u*)(KDTg + dk * 64 + p0) = pack8(kv);
        }
    }
    {
        const int p = wv >> 2, tm = wv & 3, q4 = lane >> 4, jl = lane & 15;
        const LAS bf16* Ab = p ? Qn : KB;
        bf16x8 af[4];
#pragma unroll
        for (int ks = 0; ks < 4; ++ks) af[ks] = ldfrag(Ab, 136, tm * 16, ks * 32, lane);
        const int i = tm * 16 + jl; const float gi = GC[i];
#pragma unroll
        for (int tn = 0; tn < 4; ++tn) {
            f32x4 acc = {0.f, 0.f, 0.f, 0.f};
            bf16x8 kf[4];
#pragma unroll
            for (int ks = 0; ks < 4; ++ks) kf[ks] = ldfrag(Kn, 136, tn * 16, ks * 32, lane);
#pragma unroll
            for (int ks = 0; ks < 4; ++ks) acc = MFMA16(kf[ks], af[ks], acc);
            const int j0 = tn * 16 + 4 * q4; const f32x4 gj = *(const LAS f32x4*)(GC + j0);
            float a_[4];
#pragma unroll
            for (int r = 0; r < 4; ++r) { const float d = __expf(gi - gj[r]); a_[r] = (i + p > j0 + r) ? acc[r] * d : 0.f; }
            v2u pk; pk.x = pk2(a_[0], a_[1]); pk.y = pk2(a_[2], a_[3]);
            if (p == 0) { *(LAS f32x4*)(AM + i * AMP + j0) = (f32x4){a_[0], a_[1], a_[2], a_[3]}; *(LAS v2u*)(AB + i * 72 + j0) = pk; }
            else *(v2u*)(QKg + i * 64 + tn * 16 + 4 * (((q4 & 1) << 1) | (q4 >> 1))) = pk;
        }
    }
    LBAR();
    P4_LOADROWS(chn, 0); P4_LOADGATES(chn);
    { unsigned zz = 0u; asm volatile("" : "+v"(zz));
      for (int i = ftid; i < 256 * 72 / 8; i += 512) *(LAS v4u*)(XT + i * 8) = (v4u){zz, zz, zz, zz}; }
    LBAR();
    {
        const int c = wv * 64 + lane;
        const LAS float* AMb = AM; const LAS float* Rb = RHS + c;
        asm volatile("" : "+v"(AMb), "+v"(Rb));
#pragma unroll
        for (int r = 0; r < 4; ++r) {
            if (r > 0) {
                const int q4 = lane >> 4, jl = lane & 15;
#pragma unroll
                for (int t2 = 0; t2 < 2; ++t2) {
                    const int ct = wv * 2 + t2;
                    f32x4 acc = {0.f, 0.f, 0.f, 0.f};
#pragma unroll
                    for (int ks = 0; ks < (r + 1) / 2; ++ks) acc = MFMA16(ldfrag(AB, 72, 16 * r, ks * 32, lane), ldfrag(XT, 72, ct * 16, ks * 32, lane), acc);
#pragma unroll
                    for (int e = 0; e < 4; ++e) RHS[(16 * r + 4 * q4 + e) * 256 + ct * 16 + jl] -= acc[e];
                }
                LBAR();
            }
            if (wv < 4) {
                float rh[16];
#pragma unroll
                for (int i = 0; i < 16; ++i) rh[i] = Rb[(16 * r + i) * 256];
                f32x2 s2[8];
#pragma unroll
                for (int k = 0; k < 8; ++k) s2[k] = (f32x2){0.f, 0.f};
                f32x4 an[4];
                an[0] = *(const LAS f32x4*)(AMb + (16 * r + 1) * AMP + 16 * r);
                s2[0].x = rh[0];
#pragma unroll
                for (int i = 1; i < 16; ++i) {
                    f32x4 ac[4];
#pragma unroll
                    for (int j4 = 0; j4 < (i + 3) / 4; ++j4) ac[j4] = an[j4];
                    if (i + 1 < 16) {
#pragma unroll
                        for (int j4 = 0; j4 < (i + 4) / 4; ++j4) an[j4] = *(const LAS f32x4*)(AMb + (16 * r + i + 1) * AMP + 16 * r + 4 * j4);
                    }
                    f32x2 va = {rh[i], 0.f}, vb = {0.f, 0.f};
#pragma unroll
                    for (int j4 = 0; j4 < (i + 3) / 4; ++j4) { va -= ac[j4].xy * s2[2 * j4]; vb -= ac[j4].zw * s2[2 * j4 + 1]; }
                    const f32x2 t = va + vb; const float si = t.x + t.y;
                    if (i & 1) s2[i >> 1].y = si; else s2[i >> 1].x = si;
                }
                { v4u w0, w1; w0.x = pk2(s2[0].x, s2[0].y); w0.y = pk2(s2[1].x, s2[1].y); w0.z = pk2(s2[2].x, s2[2].y); w0.w = pk2(s2[3].x, s2[3].y);
                  w1.x = pk2(s2[4].x, s2[4].y); w1.y = pk2(s2[5].x, s2[5].y); w1.z = pk2(s2[6].x, s2[6].y); w1.w = pk2(s2[7].x, s2[7].y);
                  *(LAS v4u*)(XT + c * 72 + 16 * r) = w0; *(LAS v4u*)(XT + c * 72 + 16 * r + 8) = w1; }
            }
            LBAR();
        }
    }
    {
        const int c = ftid >> 2;
#pragma unroll
        for (int h2 = 0; h2 < 2; ++h2) {
            const int i8 = 2 * (ftid & 3) + h2, base = 32 * (i8 >> 2) + 4 * ((i8 >> 1) & 1);
            const v2u lo = *(const LAS v2u*)(XT + c * 72 + base + 8 * ((2 * i8) & 3)), hi = *(const LAS v2u*)(XT + c * 72 + base + 8 * ((2 * i8 + 1) & 3));
            *(v4u*)(UTg + c * 64 + 8 * i8) = (v4u){lo.x, lo.y, hi.x, hi.y};
        }
        const int i = ftid >> 3, p0 = 16 * (ftid & 7);
#pragma unroll
        for (int h2 = 0; h2 < 2; ++h2) {
            unsigned w[4];
#pragma unroll
            for (int e2 = 0; e2 < 4; ++e2) {
                const unsigned a0 = XT[(128 + swap23(p0 + 8 * h2 + 2 * e2)) * 72 + i], a1 = XT[(128 + swap23(p0 + 8 * h2 + 2 * e2 + 1)) * 72 + i];
                w[e2] = a0 | (a1 << 16);
            }
            *(v4u*)(Wg + i * 128 + p0 + 8 * h2) = (v4u){w[0], w[1], w[2], w[3]};
        }
    }
    LBAR();
    if (publish && it <= 1 && it + 1 < nit) {
        VM_WAIT(); LBAR();
        if (ftid == 511) __hip_atomic_store((unsigned*)(F.ctl + CW_FLAG) + p4_flag_index(ch), 1u, RLX_AGENT);
    }
  }
  if (publish) {
    __syncthreads();
    if (threadIdx.x == 0) { __hip_atomic_store((unsigned*)(F.ctl + CW_FLAG) + p4_flag_index(ch0 + (nit - 1) * stride), 1u, RLX_AGENT); }
  }
}

constexpr int S5_OPB = 57344, S5_OW = 0, S5_OQG = 16384, S5_OKD = 32768, S5_OQK = 49152, S5_OX = 2 * S5_OPB, S5_OXB = 64 * 272, S5_GN = S5_OX + 2 * S5_OXB;
typedef float f32x16 __attribute__((ext_vector_type(16)));
#define MFMA32(a, b, c) __builtin_amdgcn_mfma_f32_32x32x16_bf16((a), (b), (c), 0, 0, 0)
__device__ __forceinline__ bf16x8 ldf256(const LAS unsigned char* base, int row, int chunk) { return *(const LAS bf16x8*)(base + row * 256 + ((chunk ^ (row & 15)) << 4)); }
__device__ __forceinline__ bf16x8 ldf128(const LAS unsigned char* base, int row, int chunk) { return *(const LAS bf16x8*)(base + row * 128 + ((chunk ^ ((row >> 1) & 7)) << 4)); }
__device__ __forceinline__ bf16x8 cvt8(const f32x16& x, int b) {
    v4u w; w.x = pk2(x[8 * b + 0], x[8 * b + 1]); w.y = pk2(x[8 * b + 2], x[8 * b + 3]); w.z = pk2(x[8 * b + 4], x[8 * b + 5]); w.w = pk2(x[8 * b + 6], x[8 * b + 7]);
    return __builtin_bit_cast(bf16x8, w);
}
struct ScanStage { v4u r[12]; };
struct ScanQK { v4u r[2]; };
struct ZSt { v4u z[4]; };
__device__ __forceinline__ void scan_stage_load(ScanStage& st, const unsigned char* pb, int ht) {
#pragma unroll
    for (int i = 0; i < 12; ++i) st.r[i] = __builtin_nontemporal_load((const v4u*)(pb + (size_t)(ht + 256 * i) * 16));
}
__device__ __forceinline__ void scan_qk_load(ScanQK& st, const unsigned char* pb, int ht) {
#pragma unroll
    for (int i = 0; i < 2; ++i) st.r[i] = __builtin_nontemporal_load((const v4u*)(pb + (size_t)(ht + 256 * (12 + i)) * 16));
}
__device__ __forceinline__ int scan_stage_off(int ht, int i) {
    const int p = ht + 256 * i;
    if (i < 8) { const int q = p & 1023, row = q >> 4, ch = q & 15; return (i < 4 ? S5_OW : S5_OQG) + row * 256 + ((ch ^ (row & 15)) << 4); }
    const int q = (i < 12) ? (p - 2048) : (p - 3072), row = q >> 3, ch = q & 7; return (i < 12 ? S5_OKD : S5_OQK) + row * 128 + ((ch ^ ((row >> 1) & 7)) << 4);
}
__device__ __forceinline__ void scan_stage_store(const ScanStage& st, const ScanQK& qk, LAS unsigned char* ob, int ht) {
#pragma unroll
    for (int i = 0; i < 12; ++i) { *(LAS v4u*)(ob + scan_stage_off(ht, i)) = st.r[i]; asm volatile("" ::: "memory"); }
#pragma unroll
    for (int i = 0; i < 2; ++i) { *(LAS v4u*)(ob + scan_stage_off(ht, 12 + i)) = qk.r[i]; asm volatile("" ::: "memory"); }
}
__device__ __forceinline__ unsigned scan_flag_ld(const unsigned* p) { return __hip_atomic_load(p, __ATOMIC_RELAXED, __HIP_MEMORY_SCOPE_AGENT); }
__device__ __forceinline__ void p5_scan(Frame& F, int bh, const bool waitf) {
    const int b = bh >> 2, hh = bh & 3;
    const unsigned* flg = (const unsigned*)(F.ctl + CW_FLAG) + bh * 32;
    if (waitf) {
        while ((scan_flag_ld(flg) & scan_flag_ld(flg + 1) & scan_flag_ld(flg + 2)) == 0u) __builtin_amdgcn_s_sleep(16);
        __builtin_amdgcn_fence(__ATOMIC_ACQUIRE, "agent");
    }
    const bf16* H = (const bf16*)(F.ws + WS_H); bf16* MIX = (bf16*)(F.ws + WS_MIX); const float* EGL = (const float*)(F.ws + WS_EGL);
    const unsigned char* prep0 = F.ws + WS_PREP + (size_t)((b * 32) * 4 + hh) * PREP_STRIDE;
    const int tid = F.tid, lane = F.lane, w = F.wave;
#ifndef SCAN_NO_C
    if (w < 4) {
        int lnp_ = threadIdx.x; asm volatile("" : "+v"(lnp_)); lnp_ &= 63;
        const int c = lnp_ & 31, h = lnp_ >> 5, dv = 32 * w + c;
        f32x16 S[4];
#pragma unroll
        for (int i = 0; i < 4; ++i)
#pragma unroll
            for (int g = 0; g < 16; ++g) S[i][g] = 0.f;
        int fo256[8], fo128[4];
#pragma unroll
        for (int s = 0; s < 8; ++s) fo256[s] = c * 256 + (((2 * s + h) ^ (c & 15)) << 4);
#pragma unroll
        for (int s = 0; s < 4; ++s) fo128[s] = c * 128 + (((2 * s + h) ^ ((c >> 1) & 7)) << 4);
        v4u ua[4], ub[4]; float ega, egb;
#define SCAN_ULOAD(U, EG, NCH) do { const int nc_ = (NCH) < 32 ? (NCH) : 31; const v4u* up = (const v4u*)(prep0 + (size_t)nc_ * 4 * PREP_STRIDE + PREP_UT + (size_t)dv * 128); \
            U[0] = __builtin_nontemporal_load(up + 2 * h); U[1] = __builtin_nontemporal_load(up + 2 * h + 1); U[2] = __builtin_nontemporal_load(up + 4 + 2 * h); U[3] = __builtin_nontemporal_load(up + 4 + 2 * h + 1); \
            EG = EGL[((b * 32 + nc_) * 4 + hh) * 32]; } while (0)
        SCAN_ULOAD(ua, ega, 0); SCAN_ULOAD(ub, egb, 1);
        LBAR();
#define SCAN_CHUNK(N, U, EG) do { \
            int ln_ = threadIdx.x; asm volatile("" : "+v"(ln_)); ln_ &= 63;     \
            const int c = ln_ & 31, h = ln_ >> 5, dv = 32 * w + c; \
            int vb256[8], vb128[4];                            \
            _Pragma("unroll") for (int s = 0; s < 8; ++s) { vb256[s] = fo256[s] + ((N) & 1) * S5_OPB; asm volatile("" : "+v"(vb256[s])); } \
            _Pragma("unroll") for (int s = 0; s < 4; ++s) { vb128[s] = fo128[s] + ((N) & 1) * S5_OPB; asm volatile("" : "+v"(vb128[s])); } \
            asm volatile("" : "+v"(U[0].x), "+v"(U[0].y), "+v"(U[0].z), "+v"(U[0].w), "+v"(U[1].x), "+v"(U[1].y), "+v"(U[1].z), "+v"(U[1].w)); \
            asm volatile("" : "+v"(U[2].x), "+v"(U[2].y), "+v"(U[2].z), "+v"(U[2].w), "+v"(U[3].x), "+v"(U[3].y), "+v"(U[3].z), "+v"(U[3].w), "+v"(EG)); \
            const float eg = EG; \
              \
            bf16x8 bS[8]; \
            _Pragma("unroll") for (int s = 0; s < 8; ++s) bS[s] = cvt8(S[s >> 1], s & 1); \
              \
            bf16x8 bV[4]; \
            _Pragma("unroll") for (int tt = 0; tt < 2; ++tt) { \
                bf16x8 fw[8]; \
                _Pragma("unroll") for (int s = 0; s < 8; ++s) fw[s] = LDF256(S5_OW, tt, s); \
                f32x16 a; \
                _Pragma("unroll") for (int g = 0; g < 16; ++g) a[g] = 0.f; \
                _Pragma("unroll") for (int s = 0; s < 8; ++s) a = MFMA32(fw[s], bS[s], a); \
                float u[16]; unpack8(U[2 * tt], u); unpack8(U[2 * tt + 1], u + 8); \
                _Pragma("unroll") for (int g = 0; g < 16; ++g) a[g] = u[g] - a[g]; \
                bV[2 * tt] = cvt8(a, 0); bV[2 * tt + 1] = cvt8(a, 1); \
            } \
            SCAN_ULOAD(U, EG, (N) + 2);                         \
              \
            LAS unsigned char* ox = F.lds + S5_OX + ((N) & 1) * S5_OXB; \
            _Pragma("unroll") for (int tt = 0; tt < 2; ++tt) { \
                f32x16 o; \
                _Pragma("unroll") for (int g = 0; g < 16; ++g) o[g] = 0.f; \
                { bf16x8 fq[8]; \
                  _Pragma("unroll") for (int s = 0; s < 8; ++s) fq[s] = LDF256(S5_OQG, tt, s); \
                  _Pragma("unroll") for (int s = 0; s < 8; ++s) o = MFMA32(bS[s], fq[s], o); } \
                { bf16x8 fk[4]; \
                  _Pragma("unroll") for (int s = 0; s < 4; ++s) fk[s] = LDF128(S5_OQK, tt, s); \
                  _Pragma("unroll") for (int s = 0; s < 4; ++s) o = MFMA32(bV[s], fk[s], o); } \
                  \
                _Pragma("unroll") for (int a4 = 0; a4 < 4; ++a4) { v2u pk; pk.x = pk2(o[4 * a4], o[4 * a4 + 1]); pk.y = pk2(o[4 * a4 + 2], o[4 * a4 + 3]); \
                    *(LAS v2u*)(ox + (32 * tt + c) * 272 + (32 * w + 8 * a4 + 4 * h) * 2) = pk; } \
            } \
              \
            _Pragma("unroll") for (int d = 0; d < 4; ++d) { \
                bf16x8 fd[4]; \
                _Pragma("unroll") for (int s = 0; s < 4; ++s) fd[s] = LDF128(S5_OKD, d, s); \
                f32x16 sacc = S[d] * eg; \
                _Pragma("unroll") for (int s = 0; s < 4; ++s) sacc = MFMA32(fd[s], bV[s], sacc); \
                S[d] = sacc; \
            } \
            LBAR(); } while (0)
#define LDF256(MAT, TT, S_) (*(const LAS bf16x8*)(F.lds + vb256[S_] + ((MAT) + (TT) * 8192)))
#define LDF128(MAT, TT, S_) (*(const LAS bf16x8*)(F.lds + vb128[S_] + ((MAT) + (TT) * 4096)))
#pragma unroll 1
        for (int n = 0; n < 32; n += 2) { SCAN_CHUNK(n, ua, ega); SCAN_CHUNK(n + 1, ub, egb); }
#undef SCAN_CHUNK
#undef SCAN_ULOAD
        LBAR();
        { int le_ = threadIdx.x; asm volatile("" : "+v"(le_));
          const int c = le_ & 31, h = (le_ >> 5) & 1, dv = 32 * w + c;
          float* RS = F.out + OUT_RECP + (size_t)bh * 128 * 128;
#pragma unroll
          for (int d = 0; d < 4; ++d)
#pragma unroll
              for (int g = 0; g < 16; ++g) RS[(size_t)(32 * d + (g & 3) + 8 * (g >> 2) + 4 * h) * 128 + dv] = S[d][g]; }
    }
#endif
#ifndef SCAN_NO_H
    if (w >= 4) {
        int htp_ = threadIdx.x; asm volatile("" : "+v"(htp_)); htp_ -= 256;
        const int ht = htp_, t = ht >> 2, q = ht & 3;
        const bf16* zbase = H + ((size_t)b * TP + t) * HPITCH + 2560 + hh * 128 + 32 * q;
        bf16* obase = MIX + ((size_t)b * TP + t) * DM + 512 + hh * 128 + 32 * q;
        ScanStage sa, sb, sc; ScanQK qa, qb;
        unsigned fl = 1u;
        if (waitf) fl = scan_flag_ld(flg + 3 + (htp_ >> 20));
        scan_stage_load(sa, prep0, ht); scan_qk_load(qa, prep0, ht);
        scan_stage_store(sa, qa, F.lds, ht);
        scan_stage_load(sb, prep0 + (size_t)4 * PREP_STRIDE, ht); scan_qk_load(qb, prep0 + (size_t)4 * PREP_STRIDE, ht);
        scan_stage_load(sc, prep0 + (size_t)8 * PREP_STRIDE, ht);
        LBAR();
#define SCAN_GATE(ZST, NCH) do { \
            const LAS unsigned char* oxr = F.lds + S5_OX + ((NCH) & 1) * S5_OXB + t * 272 + q * 64; \
            float ss = 0.f; \
            _Pragma("unroll") for (int i = 0; i < 4; ++i) { float o[8]; unpack8(*(const LAS v4u*)(oxr + 16 * i), o); \
                _Pragma("unroll") for (int e = 0; e < 8; ++e) ss += o[e] * o[e]; } \
            ss += __shfl_xor(ss, 1); ss += __shfl_xor(ss, 2); \
            const float rms = rsqrtf(ss * (1.0f / 128.0f) + RMS_EPS); \
            v4u* op = (v4u*)(obase + (size_t)(NCH) * 64 * DM); \
            _Pragma("unroll") for (int i = 0; i < 4; ++i) { float o[8], z[8], r[8]; unpack8(*(const LAS v4u*)(oxr + 16 * i), o); unpack8((ZST).z[i], z);     \
                _Pragma("unroll") for (int e = 0; e < 8; ++e) r[e] = o[e] * rms * z[e]; \
                op[i] = pack8(r); asm volatile("" ::: "memory"); } } while (0)
        ZSt zcur;
#pragma unroll
        for (int i = 0; i < 4; ++i) zcur.z[i] = (v4u){0u, 0u, 0u, 0u};
#define SCAN_PERIOD(N, X, Y, QX, QY) do { \
            int ht_ = htp_; asm volatile("" : "+v"(ht_));        \
            const int ht = ht_, t = ht >> 2, q = ht & 3; \
            const bf16* zbase = H + ((size_t)b * TP + t) * HPITCH + 2560 + hh * 128 + 32 * q; \
            bf16* obase = MIX + ((size_t)b * TP + t) * DM + 512 + hh * 128 + 32 * q; \
            asm volatile("" : "+v"(zcur.z[0].x), "+v"(zcur.z[0].y), "+v"(zcur.z[0].z), "+v"(zcur.z[0].w), "+v"(zcur.z[1].x), "+v"(zcur.z[1].y), "+v"(zcur.z[1].z), "+v"(zcur.z[1].w)); \
            asm volatile("" : "+v"(zcur.z[2].x), "+v"(zcur.z[2].y), "+v"(zcur.z[2].z), "+v"(zcur.z[2].w), "+v"(zcur.z[3].x), "+v"(zcur.z[3].y), "+v"(zcur.z[3].z), "+v"(zcur.z[3].w)); \
            { const int n3 = (N) + 3 < 32 ? (N) + 3 : 31, n4 = (N) + 4 < 32 ? (N) + 4 : 31; \
              if (waitf) { if (fl == 0u) { while (scan_flag_ld(flg + n3) == 0u) __builtin_amdgcn_s_sleep(8); __builtin_amdgcn_fence(__ATOMIC_ACQUIRE, "agent"); } \
                           fl = scan_flag_ld(flg + n4 + (ht_ >> 20)); } }                      \
            ZSt znext;                                        \
            _Pragma("unroll") for (int i = 0; i < 4; ++i) znext.z[i] = ((const v4u*)(zbase + (size_t)(N) * 64 * HPITCH))[i]; \
            { const int n3 = (N) + 3 < 32 ? (N) + 3 : 31, n2 = (N) + 2 < 32 ? (N) + 2 : 31; scan_stage_load(X, prep0 + (size_t)n3 * 4 * PREP_STRIDE, ht); scan_qk_load(QX, prep0 + (size_t)n2 * 4 * PREP_STRIDE, ht); } \
            if ((N) >= 1) SCAN_GATE(zcur, (N) - 1); \
            scan_stage_store(Y, QY, F.lds + (((N) + 1) & 1) * S5_OPB, ht); \
            LBAR(); \
            _Pragma("unroll") for (int i = 0; i < 4; ++i) zcur.z[i] = znext.z[i]; } while (0)
#pragma unroll 1
        for (int n = 0; n < 30; n += 6) {
            SCAN_PERIOD(n, sa, sb, qa, qb); SCAN_PERIOD(n + 1, sb, sc, qb, qa); SCAN_PERIOD(n + 2, sc, sa, qa, qb); SCAN_PERIOD(n + 3, sa, sb, qb, qa); SCAN_PERIOD(n + 4, sb, sc, qa, qb); SCAN_PERIOD(n + 5, sc, sa, qb, qa); }
        SCAN_PERIOD(30, sa, sb, qa, qb); SCAN_PERIOD(31, sb, sc, qb, qa);
        SCAN_GATE(zcur, 31);
        LBAR();
#undef SCAN_PERIOD
#undef SCAN_GATE
    }
#endif
}

__device__ __forceinline__ void p5_sample_gdn(Frame& F, int item) {
    const int b = item >> 2, hh = item & 3;
    LAS float* QS = (LAS float*)(F.lds + 0);
    LAS float* KS = QS + 512; LAS float* VS = KS + 512; LAS float* PART = VS + 512;
    LAS float* GB = PART + 16;
    LAS float* RED = GB + 8;
    LAS float* OS = RED + 512;
    const bf16* H = (const bf16*)(F.ws + WS_H); const float* gates = (const float*)(F.ws + WS_GATES); bf16* MIX = (bf16*)(F.ws + WS_MIX);
    const int tid = F.tid, lane = F.lane, t = tid >> 7, c = tid & 127;
    const size_t m = (size_t)MP + b * TS + t;
    float xv[3];
#pragma unroll
    for (int X = 0; X < 3; ++X) {
        const int col = X * 512 + hh * 128 + c; float acc = 0.f;
#pragma unroll
        for (int i = 0; i < 4; ++i) {
            const int r = t - 3 + i;
            const float raw = (r >= 0) ? bf2f(H[((size_t)MP + b * TS + r) * HPITCH + 1024 + col]) : inp(3)[((size_t)b * 3 + (3 + r)) * QKVD + col];
            acc += inp(14)[(size_t)i * QKVD + col] * raw;
            if (i == 3 && t >= 1) F.out[OUT_QKVS + ((size_t)b * 3 + (t - 1)) * QKVD + col] = raw;
        }
        xv[X] = siluf(acc);
    }
    const float sq = wave_sum(xv[0] * xv[0]), sk = wave_sum(xv[1] * xv[1]);
    if (lane == 0) { PART[F.wave] = sq; PART[8 + F.wave] = sk; }
    if (c == 0) { const float bl = gates[m * 8 + hh], al = gates[m * 8 + 4 + hh]; GB[t] = -expf(inp(15)[hh]) * softplus_f(al + inp(16)[hh]); GB[4 + t] = sigmoid_f(bl); }
    __syncthreads();
    {
        const float ssq = PART[2 * t] + PART[2 * t + 1], ssk = PART[8 + 2 * t] + PART[8 + 2 * t + 1];
        QS[t * 128 + c] = xv[0] * rsqrtf(ssq + RMS_EPS) * 0.08838834764831845f; KS[t * 128 + c] = xv[1] * rsqrtf(ssk + RMS_EPS); VS[t * 128 + c] = xv[2];
    }
    __syncthreads();
    const int dq = tid >> 7;
    const float* S0 = inp(4) + (size_t)item * 128 * 128;
    float S[32];
#pragma unroll
    for (int i = 0; i < 32; ++i) S[i] = __builtin_nontemporal_load(S0 + (size_t)(dq * 32 + i) * 128 + c);
    for (int tk = 0; tk < 4; ++tk) {
        const float eg = expf(GB[tk]), beta = GB[4 + tk];
        float kv = 0.f;
#pragma unroll
        for (int i = 0; i < 32; ++i) { S[i] *= eg; kv += S[i] * KS[tk * 128 + dq * 32 + i]; }
        RED[dq * 128 + c] = kv;
        __syncthreads();
        const float kvt = (RED[c] + RED[128 + c]) + (RED[256 + c] + RED[384 + c]);
        const float vn = beta * (VS[tk * 128 + c] - kvt);
        float o = 0.f;
#pragma unroll
        for (int i = 0; i < 32; ++i) { S[i] += KS[tk * 128 + dq * 32 + i] * vn; o += S[i] * QS[tk * 128 + dq * 32 + i]; }
        __syncthreads();
        RED[dq * 128 + c] = o;
        __syncthreads();
        if (dq == 0) OS[tk * 128 + c] = (RED[c] + RED[128 + c]) + (RED[256 + c] + RED[384 + c]);
        __syncthreads();
    }
    float* RS = F.out + OUT_RECS + (size_t)item * 128 * 128;
#pragma unroll
    for (int i = 0; i < 32; ++i) __builtin_nontemporal_store(S[i], RS + (size_t)(dq * 32 + i) * 128 + c);
    {
        const float o = OS[t * 128 + c];
        const float ss = wave_sum(o * o);
        if (lane == 0) PART[F.wave] = ss;
        __syncthreads();
        const float rms = rsqrtf((PART[2 * t] + PART[2 * t + 1]) * (1.0f / 128.0f) + RMS_EPS);
        const float z = bf2f(H[m * HPITCH + 2560 + hh * 128 + c]);
        MIX[m * DM + 512 + hh * 128 + c] = (bf16)f2bf(o * rms * z);
    }
    __syncthreads();
}

template <int TB, bool SAMPLE>
__device__ __forceinline__ void p5_conf_item(Frame& F, int b, int t0, const LAS float* cwl) {
    constexpr int T = SAMPLE ? TS : TP, R = TB + 30;
    const bf16* H = (const bf16*)(F.ws + WS_H); bf16* MIX = (bf16*)(F.ws + WS_MIX);
    int ln_ = F.lane; asm volatile("" : "+v"(ln_));
    const int ch0 = ln_ * 8;
    const size_t mbase = SAMPLE ? (size_t)MP + (size_t)b * TS : (size_t)b * TP;
    float* cout = F.out + (SAMPLE ? OUT_CONVS : OUT_CONVP) + (size_t)b * 30 * CCH;
    const bool wr_state = (t0 + TB == T);
    f32x2 acc[TB][4], wt[8][4];
#pragma unroll
    for (int i = 0; i < TB; ++i)
#pragma unroll
        for (int c = 0; c < 4; ++c) acc[i][c] = (f32x2){0.f, 0.f};
#pragma unroll
    for (int i = 0; i < 8; ++i)
#pragma unroll
        for (int c = 0; c < 4; ++c) wt[i][c] = (f32x2){0.f, 0.f};
    v4u nb[8]; v4u na = {0u, 0u, 0u, 0u}; f32x4 ns0 = {0.f, 0.f, 0.f, 0.f}, ns1 = {0.f, 0.f, 0.f, 0.f};
#pragma unroll
    for (int j = 0; j < 8; ++j) nb[j] = (v4u){0u, 0u, 0u, 0u};
    if (!SAMPLE) {
#pragma unroll
        for (int j = 0; j < 8; ++j) { const int tt = t0 - 30 + j, tc = tt < 0 ? 0 : tt; nb[j] = *(const v4u*)(H + (mbase + tc) * HPITCH + ch0); }
    } else {
        const int tt = t0 - 30;
        if (tt >= 0) na = *(const v4u*)(H + (mbase + tt) * HPITCH + ch0);
        else { const f32x4* sp = (const f32x4*)(inp(2) + ((size_t)b * 30 + (30 + tt)) * CCH + ch0); ns0 = sp[0]; ns1 = sp[1]; }
    }
#pragma unroll 1
    for (int r8 = 0; r8 < (R + 7) / 8; ++r8) {
        v4u cbk[8];
        if (!SAMPLE) {
#pragma unroll
            for (int j = 0; j < 8; ++j) cbk[j] = nb[j];
#pragma unroll
            for (int j = 0; j < 8; ++j) { const int r = 8 * (r8 + 1) + j, tt = t0 - 30 + r, tc = tt < 0 ? 0 : (tt > T - 1 ? T - 1 : tt); nb[j] = *(const v4u*)(H + (mbase + tc) * HPITCH + ch0); }
        }
#pragma unroll
        for (int j = 0; j < 8; ++j) {
            const int r = 8 * r8 + j, tt = t0 - 30 + r;
            const v4u ca = SAMPLE ? na : cbk[j]; const f32x4 cs0 = ns0, cs1 = ns1;
            if (SAMPLE && r + 1 < R) {
                const int tn = tt + 1;
                if (tn >= 0) na = *(const v4u*)(H + (mbase + tn) * HPITCH + ch0);
                else { const f32x4* sp = (const f32x4*)(inp(2) + ((size_t)b * 30 + (30 + tn)) * CCH + ch0); ns0 = sp[0]; ns1 = sp[1]; }
            }
            { const int ir = r <= 30 ? r : 31;
              const f32x4 w0 = *(const LAS f32x4*)(cwl + ir * CCH + ch0), w1 = *(const LAS f32x4*)(cwl + ir * CCH + ch0 + 4);
              wt[j][0] = (f32x2){w0[0], w0[1]}; wt[j][1] = (f32x2){w0[2], w0[3]}; wt[j][2] = (f32x2){w1[0], w1[1]}; wt[j][3] = (f32x2){w1[2], w1[3]}; }
            float u[8];
            if (!SAMPLE) {
                const unsigned mk = (r < R && tt >= 0) ? 0xffffffffu : 0u;
                v4u cm = ca; cm.x &= mk; cm.y &= mk; cm.z &= mk; cm.w &= mk; unpack8(cm, u);
            } else if (r >= R) {
#pragma unroll
                for (int c = 0; c < 8; ++c) u[c] = 0.f;
            } else if (tt >= 0) {
                unpack8(ca, u);
            } else if (SAMPLE) {
                u[0] = cs0[0]; u[1] = cs0[1]; u[2] = cs0[2]; u[3] = cs0[3]; u[4] = cs1[0]; u[5] = cs1[1]; u[6] = cs1[2]; u[7] = cs1[3];
            } else {
#pragma unroll
                for (int c = 0; c < 8; ++c) u[c] = 0.f;
            }
            if (wr_state && r < R && tt >= T - 30) { f32x4* op = (f32x4*)(cout + (size_t)(tt - (T - 30)) * CCH + ch0); op[0] = (f32x4){u[0], u[1], u[2], u[3]}; op[1] = (f32x4){u[4], u[5], u[6], u[7]}; }
            const f32x2 u2[4] = {(f32x2){u[0], u[1]}, (f32x2){u[2], u[3]}, (f32x2){u[4], u[5]}, (f32x2){u[6], u[7]}};
#pragma unroll
            for (int to = 0; to < TB; ++to) {
                const int sl = (j - to) & 7;
#pragma unroll
                for (int c = 0; c < 4; ++c) acc[to][c] += wt[sl][c] * u2[c];
            }
            if (SAMPLE) asm volatile("" ::: "memory");
        }
    }
    float cb[8], lg[8], lb[8];
#pragma unroll
    for (int c = 0; c < 8; ++c) { cb[c] = inp(11)[ch0 + c]; lg[c] = inp(12)[ch0 + c]; lb[c] = inp(13)[ch0 + c]; }
#pragma unroll
    for (int to = 0; to < TB; ++to) {
        float v[8]; float s = 0.f;
#pragma unroll
        for (int c = 0; c < 8; ++c) { v[c] = acc[to][c >> 1][c & 1] + cb[c]; s += v[c]; }
        const float mean = wave_sum(s) * (1.0f / CCH); float q = 0.f;
#pragma unroll
        for (int c = 0; c < 8; ++c) { v[c] -= mean; q += v[c] * v[c]; }
        const float rstd = rsqrtf(wave_sum(q) * (1.0f / CCH) + LN_EPS);
        float y[8];
#pragma unroll
        for (int c = 0; c < 8; ++c) y[c] = siluf(v[c] * rstd * lg[c] + lb[c]);
        *(v4u*)(MIX + (mbase + t0 + to) * DM + ch0) = pack8(y);
    }
}

constexpr int CT_WIN = 65536;
template <bool SAMPLE>
__device__ __forceinline__ void p5_conf_tile(Frame& F, int b, int t0, const LAS float* cwl) {
    constexpr int T = SAMPLE ? TS : TP;
    const bf16* H = (const bf16*)(F.ws + WS_H); bf16* MIX = (bf16*)(F.ws + WS_MIX);
    int tq_ = threadIdx.x; asm volatile("" : "+v"(tq_));
    const int tid = tq_, lane = tid & 63, wv = __builtin_amdgcn_readfirstlane(tid >> 6);
    const size_t mbase = SAMPLE ? (size_t)MP + (size_t)b * TS : (size_t)b * TP;
    float* cout = F.out + (SAMPLE ? OUT_CONVS : OUT_CONVP) + (size_t)b * 30 * CCH;
    LAS unsigned char* win = F.lds + CT_WIN;
    if (!SAMPLE) {
        v4u rw[8];
#pragma unroll
        for (int i = 0; i < 8; ++i) { const int q = tid + 512 * i, row = q >> 6, chunk = q & 63, tt = t0 - 30 + row, tc = tt < 0 ? 0 : (tt > T - 1 ? T - 1 : tt);
            rw[i] = *(const v4u*)(H + (mbase + tc) * HPITCH + chunk * 8); }
#pragma unroll
        for (int i = 0; i < 8; ++i) { const int q = tid + 512 * i, row = q >> 6, chunk = q & 63, tt = t0 - 30 + row;
            v4u v = rw[i]; if (tt < 0) v = (v4u){0u, 0u, 0u, 0u};
            *(LAS v4u*)(win + row * 1024 + chunk * 16) = v;
            if (t0 + 32 == T && tt >= T - 30 && tt < T) { float u[8]; unpack8(v, u); f32x4* op = (f32x4*)(cout + (size_t)(tt - (T - 30)) * CCH + chunk * 8); op[0] = (f32x4){u[0], u[1], u[2], u[3]}; op[1] = (f32x4){u[4], u[5], u[6], u[7]}; } }
    } else {
        f32x4 sa[4], sb[4]; v4u hv = {0u, 0u, 0u, 0u};
#pragma unroll
        for (int i = 0; i < 4; ++i) { const int q = tid + 512 * i, row = q >> 6, chunk = q & 63; const int rc = row < 30 ? row : 29;
            const f32x4* sp = (const f32x4*)(inp(2) + ((size_t)b * 30 + rc) * CCH + chunk * 8); sa[i] = __builtin_nontemporal_load(sp); sb[i] = __builtin_nontemporal_load(sp + 1); }
        const int hrow = tid >> 6, hchunk = tid & 63;
        if (tid < 256) hv = *(const v4u*)(H + (mbase + hrow) * HPITCH + hchunk * 8);
#pragma unroll
        for (int i = 0; i < 4; ++i) { const int q = tid + 512 * i, row = q >> 6, chunk = q & 63;
            if (row < 30) { const float f[8] = {sa[i][0], sa[i][1], sa[i][2], sa[i][3], sb[i][0], sb[i][1], sb[i][2], sb[i][3]};
                *(LAS v4u*)(win + row * 1024 + chunk * 16) = pack8(f);
                if (row >= 4) { f32x4* op = (f32x4*)(cout + (size_t)(row - 4) * CCH + chunk * 8); op[0] = sa[i]; op[1] = sb[i]; } } }
        if (tid < 256) { *(LAS v4u*)(win + (30 + hrow) * 1024 + hchunk * 16) = hv;
            float u[8]; unpack8(hv, u); f32x4* op = (f32x4*)(cout + (size_t)(26 + hrow) * CCH + hchunk * 8); op[0] = (f32x4){u[0], u[1], u[2], u[3]}; op[1] = (f32x4){u[4], u[5], u[6], u[7]}; }
        if (tid < 384) *(LAS v4u*)(win + (34 + (tid >> 6)) * 1024 + (tid & 63) * 16) = (v4u){0u, 0u, 0u, 0u};
    }
    __syncthreads();
    if (!SAMPLE || wv == 0) {
        const int ch0 = lane * 8, wrow0 = SAMPLE ? 0 : 4 * wv;
        const LAS unsigned char* wl = win + ch0 * 2;
        f32x2 acc[4][4], wt[8][4];
#pragma unroll
        for (int i = 0; i < 4; ++i)
#pragma unroll
            for (int c = 0; c < 4; ++c) acc[i][c] = (f32x2){0.f, 0.f};
#pragma unroll
        for (int i = 0; i < 8; ++i)
#pragma unroll
            for (int c = 0; c < 4; ++c) wt[i][c] = (f32x2){0.f, 0.f};
#pragma unroll 1
        for (int r8 = 0; r8 < 5; ++r8) {
#pragma unroll
            for (int j = 0; j < 8; ++j) {
                const int r = 8 * r8 + j; int lr = wrow0 + r; lr = lr > 63 ? 63 : lr;
                const v4u ca = *(const LAS v4u*)(wl + lr * 1024);
                { const int ir = r <= 30 ? r : 31;
                  const f32x4 w0 = *(const LAS f32x4*)(cwl + ir * CCH + ch0), w1 = *(const LAS f32x4*)(cwl + ir * CCH + ch0 + 4);
                  wt[j][0] = (f32x2){w0[0], w0[1]}; wt[j][1] = (f32x2){w0[2], w0[3]}; wt[j][2] = (f32x2){w1[0], w1[1]}; wt[j][3] = (f32x2){w1[2], w1[3]}; }
                float u[8]; unpack8(ca, u);
                const f32x2 u2[4] = {(f32x2){u[0], u[1]}, (f32x2){u[2], u[3]}, (f32x2){u[4], u[5]}, (f32x2){u[6], u[7]}};
#pragma unroll
                for (int to = 0; to < 4; ++to) {
                    const int sl = (j - to) & 7;
#pragma unroll
                    for (int c = 0; c < 4; ++c) acc[to][c] += wt[sl][c] * u2[c];
                }
            }
        }
        float cb[8], lg[8], lb[8];
#pragma unroll
        for (int c = 0; c < 8; ++c) { cb[c] = inp(11)[ch0 + c]; lg[c] = inp(12)[ch0 + c]; lb[c] = inp(13)[ch0 + c]; }
#pragma unroll
        for (int to = 0; to < 4; ++to) {
            float v[8]; float sm = 0.f;
#pragma unroll
            for (int c = 0; c < 8; ++c) { v[c] = acc[to][c >> 1][c & 1] + cb[c]; sm += v[c]; }
            const float mean = wave_sum(sm) * (1.0f / CCH); float q = 0.f;
#pragma unroll
            for (int c = 0; c < 8; ++c) { v[c] -= mean; q += v[c] * v[c]; }
            const float rstd = rsqrtf(wave_sum(q) * (1.0f / CCH) + LN_EPS);
            float y[8];
#pragma unroll
            for (int c = 0; c < 8; ++c) y[c] = siluf(v[c] * rstd * lg[c] + lb[c]);
            *(v4u*)(MIX + (mbase + t0 + wrow0 + to) * DM + ch0) = pack8(y);
        }
    }
    __syncthreads();
}

__device__ __forceinline__ void p2b_sample_rows(Frame& F, int gw, int NGW) {
    const bf16* XB = (const bf16*)(F.ws + WS_XB); const float* SL = (const float*)(F.ws + WS_SLAB1); bf16* Z1 = (bf16*)(F.out + OUT_Y); float* st1 = (float*)(F.ws + WS_ST1);
    for (int m = MP + gw; m < MTOT; m += NGW) {
        const v4u* xr = (const v4u*)(XB + (size_t)m * DM) + F.lane; float x[16]; unpack8(xr[0], x); unpack8(xr[64], x + 8);
        float z[16], s = 0.f, q = 0.f;
#pragma unroll
        for (int j = 0; j < 2; ++j)
#pragma unroll
            for (int e4 = 0; e4 < 2; ++e4) {
                const int col = 512 * j + 8 * F.lane + 4 * e4;
                f32x4 a = {0.f, 0.f, 0.f, 0.f};
#pragma unroll
                for (int sl = 0; sl < 4; ++sl) a = a + *(const f32x4*)(SL + ((size_t)sl * 512 + (m - MP)) * 1024 + col);
#pragma unroll
                for (int e = 0; e < 4; ++e) { const float zz = x[8 * j + 4 * e4 + e] * 1.189207115002721f + a[e]; z[8 * j + 4 * e4 + e] = zz; s += zz; q += zz * zz; }
            }
        s = wave_sum(s); q = wave_sum(q);
        v4u* zr = (v4u*)(Z1 + (size_t)m * DM) + F.lane; zr[0] = pack8(z); zr[64] = pack8(z + 8);
        if (F.lane == 0) { st1[2 * m] = s; st1[2 * m + 1] = q; }
    }
}

__device__ __forceinline__ void p9_final_ln(Frame& F, int row_lo, int row_hi, int gw, int NGW, bool slabs) {
    const bf16* Z3 = (const bf16*)(F.ws + WS_Z2);
    f32x4 gv[4], bv[4];
#pragma unroll
    for (int j = 0; j < 2; ++j) { gv[2 * j] = *(const f32x4*)(inp(23) + 512 * j + 8 * F.lane); gv[2 * j + 1] = *(const f32x4*)(inp(23) + 512 * j + 8 * F.lane + 4);
                                   bv[2 * j] = *(const f32x4*)(inp(24) + 512 * j + 8 * F.lane); bv[2 * j + 1] = *(const f32x4*)(inp(24) + 512 * j + 8 * F.lane + 4); }
    for (int m = row_lo + gw; m < row_hi; m += NGW) {
        const v4u* zr = (const v4u*)(Z3 + (size_t)m * DM) + F.lane;
        float v[16];
        if (slabs && m >= MP) {
            const bf16* Z2 = (const bf16*)(F.ws + WS_Z2B); const float* st2 = (const float*)(F.ws + WS_ST2); const float* SL = (const float*)(F.ws + WS_SLAB);
            const v4u* z2r = (const v4u*)(Z2 + (size_t)m * DM) + F.lane; float z2[16]; unpack8(z2r[0], z2); unpack8(z2r[64], z2 + 8);
            const float mean2 = st2[2 * m] * (1.0f / 1024.0f), var2 = st2[2 * m + 1] * (1.0f / 1024.0f) - mean2 * mean2, rstd2 = rsqrtf(fmaxf(var2, 0.f) + LN_EPS);
#pragma unroll
            for (int j = 0; j < 2; ++j)
#pragma unroll
                for (int e4 = 0; e4 < 2; ++e4) {
                    const int col = 512 * j + 8 * F.lane + 4 * e4;
                    const f32x4 g2 = *(const f32x4*)(inp(19) + col), b2 = *(const f32x4*)(inp(20) + col);
                    f32x4 a = {0.f, 0.f, 0.f, 0.f};
#pragma unroll
                    for (int sl = 0; sl < 4; ++sl) a = a + *(const f32x4*)(SL + ((size_t)sl * 512 + (m - MP)) * 1024 + col);
#pragma unroll
                    for (int e = 0; e < 4; ++e) v[8 * j + 4 * e4 + e] = ((z2[8 * j + 4 * e4 + e] - mean2) * rstd2 * g2[e] + b2[e]) * 1.189207115002721f + a[e];
                }
        } else { unpack8(zr[0], v); unpack8(zr[64], v + 8); }
        float s = 0.f;
#pragma unroll
        for (int i = 0; i < 16; ++i) s += v[i];
        const float mean = wave_sum(s) * (1.f / DM); float s2 = 0.f;
#pragma unroll
        for (int i = 0; i < 16; ++i) { v[i] -= mean; s2 += v[i] * v[i]; }
        const float rstd = rsqrtf(wave_sum(s2) * (1.f / DM) + LN_EPS);
        float* orow = F.out + (size_t)m * DM;
#pragma unroll
        for (int j = 0; j < 2; ++j) {
            f32x4 o0, o1;
#pragma unroll
            for (int e = 0; e < 4; ++e) { o0[e] = v[8 * j + e] * rstd * gv[2 * j][e] + bv[2 * j][e]; o1[e] = v[8 * j + 4 + e] * rstd * gv[2 * j + 1][e] + bv[2 * j + 1][e]; }
            __builtin_nontemporal_store(o0, (f32x4*)(orow + 512 * j + 8 * F.lane)); __builtin_nontemporal_store(o1, (f32x4*)(orow + 512 * j + 8 * F.lane + 4));
        }
    }
}

struct Args { const float* in[25]; float* out; unsigned char* ws; };
__global__ void __launch_bounds__(NWAVES * 64, 2) hymba_fwd(Args args) {
    extern __shared__ __attribute__((aligned(16))) unsigned char lds[];
    Frame F;
    F.lds = (LAS unsigned char*)lds;
    F.MISC = (volatile LAS unsigned*)(F.lds + MISC_OFF);
    F.tid = threadIdx.x; F.lane = F.tid & 63; F.wave = __builtin_amdgcn_readfirstlane(F.tid >> 6);
    F.G = gridDim.x; { const int bx = blockIdx.x; F.vcu = (F.G % 8 == 0) ? (bx % 8) * (F.G / 8) + bx / 8 : bx; }
    F.ws = args.ws; F.out = args.out; F.ctl = (gu32*)(args.ws + WS_CTL);
    for (int u = F.tid; u < (LDS_BYTES - MISC_OFF) / 4; u += NWAVES * 64) ((LAS unsigned*)(F.lds + MISC_OFF))[u] = 0u;
    __syncthreads();
    XcdBarrier bar = xcd_barrier_post((unsigned*)(F.ctl + CW_BAR), F.MISC + 8);
    if (threadIdx.x == 0) __hip_atomic_store((unsigned*)(F.ctl + CW_XCC) + blockIdx.x, xb_xcc_id() + 1u, RLX_AGENT);
#define GRID_BAR() do { xcd_barrier(bar); int t_ = threadIdx.x; asm volatile("" : "+v"(t_)); F.tid = t_; F.lane = t_ & 63; F.wave = __builtin_amdgcn_readfirstlane(t_ >> 6); } while (0)
    unsigned char* ws = args.ws;
    const int G = F.G, bx = blockIdx.x;

#ifndef PHM
#define PHM 0x3ff
#endif
#define PH(k) ((PHM >> (k)) & 1)
#ifndef DUPM
#define DUPM 0
#endif
#define REP(k) (1 + ((DUPM >> (k)) & 1))
#ifndef DUP5
#define DUP5 0
#endif
#ifndef P5M
#define P5M 15
#endif
#if PH(0)
    p0_prologue(F);
#endif
    GRID_BAR();
    if (G == 256 && bx >= 32 && threadIdx.x == 0) {
        const unsigned mine = xb_xcc_id() + 1u, scn = __hip_atomic_load((unsigned*)(F.ctl + CW_XCC) + ((bx - 32) & 31), RLX_AGENT);
        const unsigned x8 = __hip_atomic_load((unsigned*)(F.ctl + CW_XCC) + (bx & 7), RLX_AGENT);
        if (mine != scn || mine != x8) __hip_atomic_fetch_or((unsigned*)(F.ctl + CW_VIOL), 1u, RLX_AGENT);
    }
#if PH(1)
    for (int rep = 0; rep < REP(1); ++rep) {
    {
        pg8::Gemm g{(const bf16*)(ws + WS_XB), (const bf16*)(ws + WS_WUP1), MTOT, NUP, DM}; pg8::StaticOrder S; S.init(MTOT, NUP, G, bx);
        pg8::EpiSwiGLU<false> E{(bf16*)(ws + WS_HID), nullptr, nullptr, nullptr};
        pg8::gemm_phase<pg8::EpiSwiGLU<false>, pg8::StaticOrder, true, true>(F.lds + RING_OFF, g, S, E);
        if (rep == 0) { if (G == 256) { if (bx >= 172) p0_weights<2>(F, (bx - 172) * NWAVES + F.wave, (G - 172) * NWAVES); } else p0_weights<2>(F, bx * NWAVES + F.wave, G * NWAVES); }
    }
    GRID_BAR();
    }
#endif

#if PH(2)
    for (int rep = 0; rep < REP(2); ++rep) {
    {
        pg8::Gemm g{(const bf16*)(ws + WS_HID), (const bf16*)(ws + WS_WDN1), MTOT, DM, DFF}; pg8::TailOrder S; S.init(MTOT, DM, G, bx, 3);
        pg8::EpiZ<0> E{(const float*)(ws + WS_SLAB1), nullptr, (const bf16*)(ws + WS_XB), nullptr, nullptr, nullptr, (bf16*)(F.out + OUT_Y), (float*)(ws + WS_ST1), 0.5f};
        pg8::gemm_phase<pg8::EpiZ<0>, pg8::TailOrder, true, true>(F.lds + RING_OFF, g, S, E);
        if (rep == 0) { if (G == 256) { if (bx >= 128) p0_weights<1>(F, (bx - 128) * NWAVES + F.wave, (G - 128) * NWAVES); } else p0_weights<1>(F, bx * NWAVES + F.wave, G * NWAVES); }
    }
    GRID_BAR();
    }
#endif

    if (G == 256) { p2b_sample_rows(F, bx * NWAVES + F.wave, G * NWAVES); GRID_BAR(); }
#ifdef FORCE_UNFUSED
    const bool fused45 = false;
#else
    const bool fused45 = (G == 256) && (__hip_atomic_load((unsigned*)(F.ctl + CW_VIOL), RLX_AGENT) == 0u);
#endif
#if PH(3)
    {
        unsigned* ecnt = (unsigned*)(F.ctl + CW_QCTR) + 256;
        pg8::Gemm g{(const bf16*)(F.out + OUT_Y), (const bf16*)(ws + WS_WIN), MTOT, NIN, DM}; pg8::AlignedInOrder S; S.init(MTOT, NIN, G, bx, ecnt); if (!fused45) S.special = false;
        pg8::EpiH E{(bf16*)(ws + WS_H), (float*)(ws + WS_GATES), (const float*)(ws + WS_ST1), (const float*)(ws + WS_CSIN), (const float*)(ws + WS_BWIN), inp(17)};
        pg8::gemm_phase<pg8::EpiH, pg8::AlignedInOrder, true, true>(F.lds + RING_OFF, g, S, E);
        if (fused45 && (bx >> 3) >= 22) {
            const int x = bx & 7, e = (bx >> 3) - 22;
            while (__hip_atomic_load(ecnt + 16 * x, RLX_AGENT) < 112u) __builtin_amdgcn_s_sleep(16);
#pragma unroll 1
            for (int j = e; j < 28; j += 10) p4_run(F, ((x * 32 + (j >> 2)) * 4) + (j & 3), 0, 1, true);
        }
    }
    GRID_BAR();
#endif

#if PH(4)
    {
        const bool fused = fused45;
        int ch0, st4, ni4;
        if (fused) { const int c4 = bx - 32, bhp = c4 & 31, n0 = c4 >> 5; ch0 = ((bhp >> 2) * 32 + n0 + 7) * 4 + (bhp & 3); st4 = 28; ni4 = (bx < 32) ? 0 : (n0 <= 3 ? 4 : 3); }
        else { ch0 = bx; st4 = G; ni4 = (NCH - bx + G - 1) / G; }
        p4_run(F, ch0, st4, ni4, fused);
        if (!fused) GRID_BAR();
        const bool split = (G >= 64); const int nscan = split ? 32 : G, noth = split ? G - 32 : G, oid = split ? bx - 32 : bx;
        { int t_ = threadIdx.x; asm volatile("" : "+v"(t_)); F.tid = t_; F.lane = t_ & 63; F.wave = __builtin_amdgcn_readfirstlane(t_ >> 6); }
        if (!split || bx < 32) { for (int it = bx; it < NBP * NH; it += nscan) p5_scan(F, it, fused); }
        { int t_ = threadIdx.x; asm volatile("" : "+v"(t_)); F.tid = t_; F.lane = t_ & 63; F.wave = __builtin_amdgcn_readfirstlane(t_ >> 6); }
        {
            __syncthreads();
            LAS float* cwl = (LAS float*)(F.lds + 0);
            for (int i = F.tid; i < 32 * CCH / 4; i += NWAVES * 64) ((LAS f32x4*)cwl)[i] = (i < CWID * CCH / 4) ? ((const f32x4*)inp(10))[i] : (f32x4){0.f, 0.f, 0.f, 0.f};
            __syncthreads();
            unsigned* qc = (unsigned*)(F.ctl + CW_QCTR);
            const int nstat = split ? G - 32 : G;
            const int rank = !split ? bx : (bx < 32 ? -1 : (fused ? (oid >= 128 ? oid - 128 : oid + 96) : oid));
            constexpr int NCT = MP / 32 + NBS, NIT = NCT + NBS * NH;
            {
                unsigned raw = 0u;
                if (threadIdx.x == 0) F.MISC[20] = (rank >= 0) ? (unsigned)rank : (unsigned)nstat + __hip_atomic_fetch_add(qc, 1u, RLX_AGENT);
                __syncthreads();
                for (;;) {
                    const int it = (int)F.MISC[20];
                    if (it >= NIT) break;
                    if (threadIdx.x == 0) raw = (unsigned)nstat + __hip_atomic_fetch_add(qc, 1u, RLX_AGENT);
                    { int t_ = threadIdx.x; asm volatile("" : "+v"(t_)); F.tid = t_; F.lane = t_ & 63; F.wave = __builtin_amdgcn_readfirstlane(t_ >> 6); }
                    if (it < MP / 32) p5_conf_tile<false>(F, it >> 6, (it & 63) * 32, cwl);
                    else if (it < NCT) p5_conf_tile<true>(F, it - MP / 32, 0, cwl);
                    else p5_sample_gdn(F, it - NCT);
                    if (threadIdx.x == 0) F.MISC[20] = raw;
                    __syncthreads();
                }
            }
        }
    }
    GRID_BAR();
#endif

#if PH(6)
    for (int rep = 0; rep < REP(6); ++rep) {
    {
        pg8::Gemm g{(const bf16*)(ws + WS_MIX), (const bf16*)(ws + WS_WOUT), MTOT, DM, DM}; pg8::TailOrder S; S.init(MTOT, DM, G, bx);
        pg8::EpiZ<1> E{nullptr, nullptr, (const bf16*)(F.out + OUT_Y), (const float*)(ws + WS_ST1), inp(7), inp(8), (bf16*)(ws + WS_Z2B), (float*)(ws + WS_ST2), 1.0f};
        pg8::gemm_phase<pg8::EpiZ<1>, pg8::TailOrder, true, true>(F.lds + RING_OFF, g, S, E);
    }
    GRID_BAR();
    }
#endif

#if PH(7)
    for (int rep = 0; rep < REP(7); ++rep) {
    {
        pg8::Gemm g{(const bf16*)(ws + WS_Z2B), (const bf16*)(ws + WS_WUP2), MTOT, NUP, DM}; pg8::StaticOrder S; S.init(MTOT, NUP, G, bx);
        pg8::EpiSwiGLU<true> E{(bf16*)(ws + WS_HID2), (const float*)(ws + WS_ST2), (const float*)(ws + WS_CSUP2), (const float*)(ws + WS_BWUP2)};
        pg8::gemm_phase<pg8::EpiSwiGLU<true>, pg8::StaticOrder, true, true>(F.lds + RING_OFF, g, S, E);
    }
    GRID_BAR();
    }
#endif

#if PH(8)
    for (int rep = 0; rep < REP(8); ++rep) {
    {
        pg8::Gemm g{(const bf16*)(ws + WS_HID2), (const bf16*)(ws + WS_WDN2), MTOT, DM, DFF}; pg8::TailOrder S; S.init(MTOT, DM, G, bx, 3);
        pg8::EpiZ<2> E{(const float*)(ws + WS_SLAB), nullptr, (const bf16*)(ws + WS_Z2B), (const float*)(ws + WS_ST2), inp(19), inp(20), (bf16*)(ws + WS_Z2), nullptr, 0.5f};
        pg8::gemm_phase<pg8::EpiZ<2>, pg8::TailOrder, true, true>(F.lds + RING_OFF, g, S, E);
    }
    GRID_BAR();
    }
#endif
#if PH(9)
    p9_final_ln(F, 0, MTOT, F.vcu * NWAVES + F.wave, F.G * NWAVES, F.G == 256);
#endif
}

extern "C" void kernel_launch(void* const* d_in, const int* in_sizes, int n_in, void* d_out, int out_size, void* d_ws, size_t ws_size, hipStream_t stream) {
    static int grid = 0;
    if (grid == 0) {
        if (n_in != 25 || in_sizes[0] != MP * DM || (size_t)out_size != OUT_TOTAL || ws_size < WS_END) { fprintf(stderr, "kernel_launch: unexpected shapes (n_in %d, in0 %d, out %d, ws %zu)\n", n_in, n_in > 0 ? in_sizes[0] : -1, out_size, ws_size); grid = -1; return; }
        int dev = 0, cus = 0, per_cu = 0;
        if (hipGetDevice(&dev) != hipSuccess || hipDeviceGetAttribute(&cus, hipDeviceAttributeMultiprocessorCount, dev) != hipSuccess) { grid = -1; return; }
        if (hipFuncSetAttribute((const void*)hymba_fwd, hipFuncAttributeMaxDynamicSharedMemorySize, LDS_BYTES) != hipSuccess) { fprintf(stderr, "kernel_launch: hipFuncSetAttribute failed\n"); grid = -1; return; }
        if (hipOccupancyMaxActiveBlocksPerMultiprocessor(&per_cu, (const void*)hymba_fwd, NWAVES * 64, LDS_BYTES) != hipSuccess || per_cu < 1) { fprintf(stderr, "kernel_launch: occupancy query says %d blocks per CU\n", per_cu); per_cu = 1; }
        (void)hipGetLastError();
        grid = cus;
    }
    if (grid < 0) return;
    (void)hipMemsetAsync((char*)d_ws + WS_CTL, 0, CTL_ZERO_BYTES, stream);
    Args a{};
    for (int i = 0; i < 25; ++i) a.in[i] = (const float*)d_in[i];
    a.out = (float*)d_out; a.ws = (unsigned char*)d_ws;
    hipLaunchKernelGGL(hymba_fwd, dim3(grid), dim3(NWAVES * 64), LDS_BYTES, stream, a);
}
```

```cpp
#include <hip/hip_runtime.h>
#include <cstdio>
#include <cstdint>

namespace pg8 {
#define PG8_LAS __attribute__((address_space(3)))
typedef unsigned short bf16_t;
typedef short bf16x8 __attribute__((ext_vector_type(8)));
typedef float f32x4 __attribute__((ext_vector_type(4)));
typedef unsigned u32x4 __attribute__((ext_vector_type(4)));
constexpr int BM = 256, BK = 64, HALF = 128, HTB = HALF * BK * 2  , STAGE_BYTES = 8 * HTB, NXCD = 8, WGM = 8;

__host__ __device__ __forceinline__ int lds_byte(int r, int c) { const int st = (r >> 4) * 2 + (c >> 5), rr = r & 15, cc = c & 31, ob = rr * 64 + cc * 2; return st * 1024 + (ob ^ (((ob >> 9) & 1) << 5)); }
__host__ __device__ __forceinline__ void stage_rc(int b, int& R, int& C) { const int st = b / 1024, sb = b % 1024, swz = sb ^ (((sb >> 9) & 1) << 5); R = (st >> 1) * 16 + swz / 64; C = (st & 1) * 32 + (swz % 64) / 2; }
__host__ __device__ __forceinline__ int perm32(int rho) { const int n = rho >> 4, i = rho & 15; return 8 * (i >> 2) + 4 * n + (i & 3); }

struct Unit { int pm, pn, row0, nai, bjm, k0, ntk, slab; };
struct Gemm { const bf16_t* A; const bf16_t* Bt; int M, N, K; };

struct StaticOrder {
    int nM, nN, nwg, G, c;
    __host__ __device__ void init(int M, int N, int G_, int c_) { nM = M / BM; nN = N / BM; nwg = nM * nN; G = G_; c = c_; }
    __host__ __device__ bool next(int i, Unit& u) const {
        const long L = (long)i * G + c; if (L >= nwg) return false;
        int wgid = (int)L; { const int q = nwg / NXCD, r = nwg % NXCD, xcd = wgid % NXCD, off = wgid / NXCD; wgid = (xcd < r ? xcd * (q + 1) : r * (q + 1) + (xcd - r) * q) + off; }
        const int nig = WGM * nN, gid = wgid / nig, fm = gid * WGM, gsz = (nM - fm) < WGM ? (nM - fm) : WGM;
        u.pm = fm + ((wgid % nig) % gsz); u.pn = (wgid % nig) / gsz; u.row0 = u.pm * BM; u.nai = 2; u.bjm = 3; u.k0 = 0; u.ntk = 0; u.slab = -1; return true;
    }
    __device__ __forceinline__ void a_ready(const Unit&) const {}
    __device__ __forceinline__ void done(const Unit&) const {}
};

struct AlignedInOrder {
    StaticOrder so; int c; bool special; unsigned* cnt;
    __host__ __device__ static int tile_of(int p) { return p == 0 ? 12 : (p <= 6 ? p + 3 : (p <= 8 ? p + 3 : p - 9)); }
    __host__ __device__ void init(int M, int N, int G_, int c_, unsigned* cnt_) { c = c_; cnt = cnt_; special = (G_ == 256 && M == 66 * BM && N == 13 * BM); so.init(M, N, G_, c_); }
    __host__ __device__ bool next(int i, Unit& u) const {
        if (!special) return so.next(i, u);
        const int xcd = c & 7, pos = c >> 3;
        if (i >= 2 && pos >= 22) return false;
        const int l = i < 2 ? 32 * i + pos : 64 + 22 * (i - 2) + pos;
        if (i >= 4) return false;
        if (l < 104) { u.pm = 8 * xcd + (l & 7); u.pn = tile_of(l >> 3); }
        else { const int sidx = (l - 104) * 8 + xcd; if (l >= 108 || sidx >= 26) return false; u.pm = 64 + sidx / 13; u.pn = tile_of(sidx % 13); }
        u.row0 = u.pm * BM; u.nai = 2; u.bjm = 3; u.k0 = 0; u.ntk = 0; u.slab = -1; return true;
    }
    __device__ __forceinline__ void a_ready(const Unit&) const {}
    __device__ __forceinline__ void done(const Unit& u) const {
        if (special && u.pm < 64 && (u.pm & 7) < 2 && (u.pn == 12 || (u.pn >= 4 && u.pn <= 9))) {
            asm volatile("s_waitcnt vmcnt(0)" ::: "memory");
            if ((threadIdx.x & 63) == 0) __hip_atomic_fetch_add(cnt + 16 * (u.pm >> 3), 1u, __ATOMIC_RELAXED, __HIP_MEMORY_SCOPE_AGENT);
        }
    }
};

struct TailOrder {
    StaticOrder so; int nfull_rounds, G, c, M, N, mode; bool special;
    __host__ __device__ void init(int M_, int N_, int G_, int c_, int mode_ = 0) { M = M_; N = N_; G = G_; c = c_; mode = mode_; special = (G_ == 256 && N_ == 1024 && M_ == 66 * BM);
        if (special) so.init(64 * BM, N_, G_, c_); else so.init(M_, N_, G_, c_); }
    __host__ __device__ bool next(int i, Unit& u) const {
        if (!special) return so.next(i, u);
        if (mode == 2) { if (i != 0) return false; i = 1; } else { if (i == 0) return so.next(0, u); if (mode == 1) return false; }
        if (i == 1 && mode == 3) {
            if (c >= 128) return false;
            const int q = c >> 2, sl = c & 3; u.pm = 64 + (q >> 4); u.pn = (q >> 1) & 3; u.row0 = 64 * BM + (q >> 3) * HALF; u.nai = 1; u.bjm = 1 << (q & 1);
            u.k0 = sl == 0 ? 0 : (sl == 1 ? 12 : (sl == 2 ? 22 : 34)); u.ntk = (sl & 1) ? 10 : 12; u.slab = sl; return true; }
        if (i == 1 && c < 32) { u.pm = 64 + (c >> 4); u.pn = (c >> 1) & 3; u.row0 = 64 * BM + (c >> 3) * HALF; u.nai = 1; u.bjm = 1 << (c & 1); u.k0 = 0; u.ntk = 0; u.slab = -1; return true; }
        return false;
    }
    __device__ __forceinline__ void a_ready(const Unit&) const {}
    __device__ __forceinline__ void done(const Unit&) const {}
};

struct SigTailOrder {
    TailOrder to; unsigned* pcnt; unsigned* ucnt; unsigned* scnt; bool on;
    __host__ __device__ void init(int M, int N, int G_, int c_, unsigned* pcnt_, unsigned* ucnt_, unsigned* scnt_, bool on_) { to.init(M, N, G_, c_, 0); pcnt = pcnt_; ucnt = ucnt_; scnt = scnt_; on = on_ && to.special; }
    __host__ __device__ bool next(int i, Unit& u) const {
        if (!on) return to.next(i, u);
        if (i == 0) return to.so.next(0, u);
        if (i != 1 || to.c < 224) return false;
        const int cc = to.c - 224; u.pm = 64 + (cc >> 4); u.pn = (cc >> 1) & 3; u.row0 = 64 * BM + (cc >> 3) * HALF; u.nai = 1; u.bjm = 1 << (cc & 1); u.k0 = 0; u.ntk = 0; u.slab = -1; return true;
    }
    __device__ __forceinline__ void a_ready(const Unit&) const {}
    __device__ __forceinline__ void done(const Unit& u) const {
        if (!on) return;
        asm volatile("s_waitcnt vmcnt(0)" ::: "memory");
        int t_ = threadIdx.x; asm volatile("" : "+v"(t_));
        if ((t_ & 63) == 0) {
            if (u.pm < 64) __hip_atomic_fetch_add(pcnt + 16 * u.pm, 1u, __ATOMIC_RELAXED, __HIP_MEMORY_SCOPE_AGENT);
            else { const int qi = ((u.row0 - 64 * BM) / HALF) * 8 + u.pn * 2 + (u.bjm >> 1);
                   const unsigned old = __hip_atomic_fetch_add(ucnt + 16 * qi, 1u, __ATOMIC_RELAXED, __HIP_MEMORY_SCOPE_AGENT);
                   if (old == 7u) { __builtin_amdgcn_fence(__ATOMIC_RELEASE, "agent"); __hip_atomic_fetch_add(scnt, 8u, __ATOMIC_RELAXED, __HIP_MEMORY_SCOPE_AGENT); } }
        }
    }
};
struct GatedUp22 {
    StaticOrder so; int c; bool special; const unsigned* pcnt; const unsigned* scnt; mutable bool prdy, srdy;
    __host__ __device__ void init(int M, int N, int G_, int c_, const unsigned* pcnt_, const unsigned* scnt_, bool on) { c = c_; pcnt = pcnt_; scnt = scnt_; prdy = false; srdy = false;
        special = on && (G_ == 256 && M == 66 * BM && N == 22 * BM); so.init(M, N, G_, c_); }
    __host__ __device__ bool next(int i, Unit& u) const {
        if (!special) return so.next(i, u);
        const int xcd = c & 7, l = 32 * i + (c >> 3);
        if (l < 176) { u.pn = l >> 3; u.pm = 8 * xcd + (l & 7); }
        else { const int sidx = (l - 176) * 8 + xcd; if (l >= 182 || sidx >= 44) return false; u.pm = 64 + sidx / 22; u.pn = sidx % 22; }
        u.row0 = u.pm * BM; u.nai = 2; u.bjm = 3; u.k0 = 0; u.ntk = 0; u.slab = -1; return true;
    }
    __device__ __forceinline__ void a_ready(const Unit& u) const {
        if (!special) return;
        if (u.pm < 64) { if (!prdy) { while (__hip_atomic_load(pcnt + 16 * u.pm, __ATOMIC_RELAXED, __HIP_MEMORY_SCOPE_AGENT) < 32u) __builtin_amdgcn_s_sleep(4); prdy = true; } }
        else if (!srdy) { while (__hip_atomic_load(scnt, __ATOMIC_RELAXED, __HIP_MEMORY_SCOPE_AGENT) < 256u) __builtin_amdgcn_s_sleep(8); __builtin_amdgcn_fence(__ATOMIC_ACQUIRE, "agent"); srdy = true; }
    }
    __device__ __forceinline__ void done(const Unit&) const {}
};

typedef float f32x2 __attribute__((ext_vector_type(2)));
typedef __bf16 bf16x2_t __attribute__((ext_vector_type(2)));
__device__ __forceinline__ unsigned cvt_pk_bf16(float lo, float hi) { const f32x2 v = {lo, hi}; return __builtin_bit_cast(unsigned, __builtin_convertvector(v, bf16x2_t)); }
typedef unsigned u32x2 __attribute__((ext_vector_type(2)));
constexpr float DN_ALPHA = 1.189207115002721f;
__device__ __forceinline__ float silu_f(float x) { return x * __builtin_amdgcn_rcpf(1.0f + __expf(-x)); }
__device__ __forceinline__ void row_stats(const float* st, int row, float& mean, float& rstd) {
    const f32x2 v = *(const f32x2*)(st + 2 * (size_t)row);
    mean = v.x * (1.0f / 1024.0f); const float var = v.y * (1.0f / 1024.0f) - mean * mean; rstd = rsqrtf(fmaxf(var, 0.f) + 1e-5f);
}

template <bool FOLD> struct EpiSwiGLU {
    static constexpr bool PERM = true, AFTER_DRAIN = false;
    bf16_t* O; const float* st; const float* cs; const float* bw;
    __device__ __forceinline__ void operator()(const f32x4 (&acc)[2][2][4][2], const Unit& u, int wr, int wc, int fr, int fq) const {
        const int row0 = u.row0 + wr * 64 + fr, cl = wc * 32 + 8 * fq;
        f32x4 csv[2][2], bwv[2][2];
        if (FOLD) {
#pragma unroll
            for (int bj = 0; bj < 2; ++bj)
#pragma unroll
                for (int n = 0; n < 2; ++n) { csv[bj][n] = *(const f32x4*)(cs + u.pn * BM + bj * HALF + cl + 4 * n); bwv[bj][n] = *(const f32x4*)(bw + u.pn * BM + bj * HALF + cl + 4 * n); }
        }
#pragma unroll
        for (int ai = 0; ai < 2; ++ai) if (ai < u.nai)
#pragma unroll
            for (int m = 0; m < 4; ++m) {
                const int row = row0 + ai * HALF + m * 16;
                float mean = 0.f, rstd = 1.f; if (FOLD) row_stats(st, row, mean, rstd);
                const float mr = mean * rstd;
                u32x4 w;
#pragma unroll
                for (int n = 0; n < 2; ++n) {
                    f32x4 a = acc[ai][0][m][n], b = acc[ai][1][m][n];
                    if (FOLD) { a = a * rstd - csv[0][n] * mr + bwv[0][n]; b = b * rstd - csv[1][n] * mr + bwv[1][n]; }
                    const float h0 = silu_f(a[0]) * b[0], h1 = silu_f(a[1]) * b[1], h2 = silu_f(a[2]) * b[2], h3 = silu_f(a[3]) * b[3];
                    if (n == 0) { w.x = cvt_pk_bf16(h0, h1); w.y = cvt_pk_bf16(h2, h3); } else { w.z = cvt_pk_bf16(h0, h1); w.w = cvt_pk_bf16(h2, h3); }
                }
                *(u32x4*)(O + (size_t)row * 2816 + u.pn * HALF + cl) = w;
            }
    }
};

struct EpiH {
    static constexpr bool PERM = true, AFTER_DRAIN = false;
    bf16_t* H; float* gates; const float* st; const float* cs; const float* bw; const float* gn;
    __device__ __forceinline__ void operator()(const f32x4 (&acc)[2][2][4][2], const Unit& u, int wr, int wc, int fr, int fq) const {
        const int row0 = u.row0 + wr * 64 + fr, cl = wc * 32 + 8 * fq;
        f32x4 csv[2][2], bwv[2][2];
#pragma unroll
        for (int bj = 0; bj < 2; ++bj)
#pragma unroll
            for (int n = 0; n < 2; ++n) { csv[bj][n] = *(const f32x4*)(cs + u.pn * BM + bj * HALF + cl + 4 * n); bwv[bj][n] = *(const f32x4*)(bw + u.pn * BM + bj * HALF + cl + 4 * n); }
        const bool zt = (u.pn == 10 || u.pn == 11);
        f32x4 gnv[2] = {(f32x4){1.f, 1.f, 1.f, 1.f}, (f32x4){1.f, 1.f, 1.f, 1.f}};
        if (zt) { gnv[0] = *(const f32x4*)(gn + cl); gnv[1] = *(const f32x4*)(gn + cl + 4); }
#pragma unroll
        for (int ai = 0; ai < 2; ++ai) if (ai < u.nai)
#pragma unroll
            for (int m = 0; m < 4; ++m) {
                const int row = row0 + ai * HALF + m * 16;
                float mean, rstd; row_stats(st, row, mean, rstd);
                const float mr = mean * rstd;
                if (u.pn < 4) {
                    u32x4 w;
#pragma unroll
                    for (int n = 0; n < 2; ++n) {
                        const f32x4 a = acc[ai][0][m][n] * rstd - csv[0][n] * mr + bwv[0][n], g = acc[ai][1][m][n] * rstd - csv[1][n] * mr + bwv[1][n];
                        const float u0 = a[0] * __builtin_amdgcn_rcpf(1.0f + __expf(-g[0])), u1 = a[1] * __builtin_amdgcn_rcpf(1.0f + __expf(-g[1])), u2 = a[2] * __builtin_amdgcn_rcpf(1.0f + __expf(-g[2])), u3 = a[3] * __builtin_amdgcn_rcpf(1.0f + __expf(-g[3]));
                        if (n == 0) { w.x = cvt_pk_bf16(u0, u1); w.y = cvt_pk_bf16(u2, u3); } else { w.z = cvt_pk_bf16(u0, u1); w.w = cvt_pk_bf16(u2, u3); }
                    }
                    *(u32x4*)(H + (size_t)row * 3072 + u.pn * HALF + cl) = w;
                } else
#pragma unroll
                for (int bj = 0; bj < 2; ++bj) {
                    f32x4 v0 = acc[ai][bj][m][0] * rstd - csv[bj][0] * mr + bwv[bj][0], v1 = acc[ai][bj][m][1] * rstd - csv[bj][1] * mr + bwv[bj][1];
                    if (zt) {
#pragma unroll
                        for (int e = 0; e < 4; ++e) { v0[e] = silu_f(v0[e]) * gnv[0][e]; v1[e] = silu_f(v1[e]) * gnv[1][e]; } }
                    if (u.pn < 12) { u32x4 w; w.x = cvt_pk_bf16(v0[0], v0[1]); w.y = cvt_pk_bf16(v0[2], v0[3]); w.z = cvt_pk_bf16(v1[0], v1[1]); w.w = cvt_pk_bf16(v1[2], v1[3]);
                        *(u32x4*)(H + (size_t)row * 3072 + u.pn * BM + bj * HALF + cl) = w; }
                    else if (bj == 0 && cl == 0) { *(f32x4*)(gates + (size_t)row * 8) = v0; *(f32x4*)(gates + (size_t)row * 8 + 4) = v1; }
                }
            }
    }
};

template <int MODE> struct EpiZ {
    static constexpr bool PERM = false, AFTER_DRAIN = false;
    const float* resP; const float* resS; const bf16_t* resB; const float* stp; const float* g; const float* b;
    bf16_t* Zb; float* sto; float scale;
    __device__ __forceinline__ void operator()(const f32x4 (&acc)[2][2][4][2], const Unit& u, int wr, int wc, int fr, int fq) const {
        const int col0 = u.pn * BM + wc * 32 + 4 * fq;
        if (MODE != 1 && u.slab >= 0) {
            float* sb = const_cast<float*>(resP) + (size_t)u.slab * 512 * 1024;
#pragma unroll
            for (int m = 0; m < 4; ++m) { const int row = u.row0 + wr * 64 + m * 16 + fr - 16384;
#pragma unroll
                for (int bj = 0; bj < 2; ++bj) if ((u.bjm >> bj) & 1)
#pragma unroll
                    for (int n = 0; n < 2; ++n) *(f32x4*)(sb + (size_t)row * 1024 + col0 + bj * HALF + n * 16) = acc[0][bj][m][n] * scale; }
            return;
        }
#pragma unroll
        for (int ai = 0; ai < 2; ++ai) if (ai < u.nai)
#pragma unroll
            for (int m = 0; m < 4; ++m) {
                const int rl = ai * HALF + wr * 64 + m * 16 + fr, row = u.row0 + rl;
                float mean = 0.f, rstd = 1.f; if (MODE >= 1) row_stats(stp, row, mean, rstd);
                float s = 0.f, q = 0.f;
#pragma unroll
                for (int bj = 0; bj < 2; ++bj) if ((u.bjm >> bj) & 1)
#pragma unroll
                    for (int n = 0; n < 2; ++n) {
                        const size_t off = (size_t)col0 + bj * HALF + n * 16;
                        f32x4 r;
                        { const u32x2 rb = *(const u32x2*)(resB + (size_t)row * 1024 + off);
                            r[0] = __builtin_bit_cast(float, rb.x << 16); r[1] = __builtin_bit_cast(float, rb.x & 0xffff0000u); r[2] = __builtin_bit_cast(float, rb.y << 16); r[3] = __builtin_bit_cast(float, rb.y & 0xffff0000u); }
                        if (MODE >= 1) { const f32x4 gvv = *(const f32x4*)(g + off), bvv = *(const f32x4*)(b + off); r = (r - mean) * rstd * gvv + bvv; }
                        const f32x4 z = r * DN_ALPHA + acc[ai][bj][m][n] * scale;
                        { u32x2 w; w.x = cvt_pk_bf16(z[0], z[1]); w.y = cvt_pk_bf16(z[2], z[3]); *(u32x2*)(Zb + (size_t)row * 1024 + off) = w; }
                        if (MODE < 2) {
                            s += (z[0] + z[1]) + (z[2] + z[3]); q += (z[0] * z[0] + z[1] * z[1]) + (z[2] * z[2] + z[3] * z[3]); }
                    }
                if (MODE < 2) { s += __shfl_xor(s, 16); s += __shfl_xor(s, 32); q += __shfl_xor(q, 16); q += __shfl_xor(q, 32);
                    if (fq == 0) { unsafeAtomicAdd(sto + 2 * (size_t)row, s); unsafeAtomicAdd(sto + 2 * (size_t)row + 1, q); } }
            }
    }
};

template <class Epi, class Sched, bool ALIGN_EPI = false, bool SP2 = false>
__device__ __forceinline__ void gemm_phase(PG8_LAS unsigned char* lds, const Gemm g, const Sched& S, const Epi& E) {
    int tid_ = threadIdx.x; asm volatile("" : "+v"(tid_));
    const int tid = tid_, wid = __builtin_amdgcn_readfirstlane(tid >> 6), lane = tid & 63, wr = wid >> 2, wc = wid & 3, fr = lane & 15, fq = lane >> 4;
    const int K = g.K, nt = K / BK;
    unsigned voffA[2], voffB[2];
#pragma unroll
    for (int i = 0; i < 2; ++i) { int R, C; stage_rc(tid * 16 + i * 8192, R, C); const int Rb = Epi::PERM ? ((R & ~31) + perm32(R & 31)) : R;
        voffA[i] = (unsigned)(R * K + C) * 2u; voffB[i] = (unsigned)(Rb * K + C) * 2u; }
    const size_t kstep = (size_t)(BK * 2);
    const size_t hstep = (size_t)HALF * K * 2;
    const size_t tstep = 2 * hstep;
    const unsigned ldsw = (unsigned)wid * 1024u;
    const int aoff = lds_byte(wr * 64 + fr, fq * 8), boff = lds_byte(wc * 32 + fr, fq * 8);
#define PG8_SA(b, h) (((b) * 2 + (h)) * HTB)
#define PG8_SB(b, h) ((4 + (b) * 2 + (h)) * HTB)
#define PG8_STAGE(bufoff, gbase, voff) do { _Pragma("unroll") for (int _i = 0; _i < 2; ++_i) \
        __builtin_amdgcn_global_load_lds((const unsigned*)((const char*)(gbase) + (voff)[_i]), (PG8_LAS unsigned*)(lds + (bufoff) + ldsw + _i * 8192), 16, 0, 0); } while (0)
#define PG8_LDA(dst, b, h) do { _Pragma("unroll") for (int m = 0; m < 4; ++m) _Pragma("unroll") for (int k = 0; k < 2; ++k) dst[m][k] = *(const PG8_LAS bf16x8*)(lds + PG8_SA(b, h) + aoff + m * 2048 + k * 1024); } while (0)
#define PG8_LDB(dst, b, h) do { _Pragma("unroll") for (int n = 0; n < 2; ++n) _Pragma("unroll") for (int k = 0; k < 2; ++k) dst[n][k] = *(const PG8_LAS bf16x8*)(lds + PG8_SB(b, h) + boff + n * 2048 + k * 1024); } while (0)
#define PG8_MMA(ai, bj, At, Bt) do { __builtin_amdgcn_s_setprio(1); _Pragma("unroll") for (int m = 0; m < 4; ++m) _Pragma("unroll") for (int n = 0; n < 2; ++n) _Pragma("unroll") for (int k = 0; k < 2; ++k) \
        acc[ai][bj][m][n] = __builtin_amdgcn_mfma_f32_16x16x32_bf16(Bt[n][k], At[m][k], acc[ai][bj][m][n], 0, 0, 0); __builtin_amdgcn_s_setprio(0); } while (0)
#define PG8_WAIT_V(n) asm volatile("s_waitcnt vmcnt(" #n ")" ::: "memory")
#define PG8_WAIT_L(n) asm volatile("s_waitcnt lgkmcnt(" #n ")" ::: "memory")
#define PG8_BAR __builtin_amdgcn_s_barrier()
#define PG8_SCHED __builtin_amdgcn_sched_barrier(0)
    Unit cur, nxt; int ui = 0;
    if (!S.next(0, cur)) return;
    f32x4 acc[2][2][4][2];
#pragma unroll
    for (int a = 0; a < 2; ++a)
#pragma unroll
        for (int b = 0; b < 2; ++b)
#pragma unroll
            for (int m = 0; m < 4; ++m)
#pragma unroll
                for (int n = 0; n < 2; ++n) acc[a][b][m][n] = (f32x4){0.f, 0.f, 0.f, 0.f};
    bf16x8 At[4][2], B0[2][2], B1[2][2];
    const char* cA = (const char*)g.A + (size_t)cur.row0 * K * 2 + (size_t)cur.k0 * kstep; const char* cB = (const char*)g.Bt + (size_t)cur.pn * tstep + (size_t)cur.k0 * kstep;
    S.a_ready(cur);
    if constexpr (SP2) {
        PG8_STAGE(PG8_SB(0, 0), cB, voffB); PG8_STAGE(PG8_SB(0, 1), cB + hstep, voffB); PG8_STAGE(PG8_SA(0, 0), cA, voffA); PG8_STAGE(PG8_SA(0, 1), cA + hstep, voffA);
        if (wr == 1) PG8_BAR;
        PG8_WAIT_V(2); PG8_BAR;
        PG8_STAGE(PG8_SB(1, 0), cB + kstep, voffB); PG8_STAGE(PG8_SA(1, 0), cA + kstep, voffA); PG8_STAGE(PG8_SB(1, 1), cB + hstep + kstep, voffB);
        PG8_WAIT_V(6); PG8_BAR;
    } else {
        PG8_STAGE(PG8_SB(0, 0), cB, voffB); PG8_STAGE(PG8_SA(0, 0), cA, voffA); PG8_STAGE(PG8_SB(0, 1), cB + hstep, voffB); PG8_STAGE(PG8_SA(0, 1), cA + hstep, voffA);
        if (wr == 1) PG8_BAR;
        PG8_WAIT_V(4); PG8_BAR;
        PG8_STAGE(PG8_SB(1, 0), cB + kstep, voffB); PG8_STAGE(PG8_SA(1, 0), cA + kstep, voffA); PG8_STAGE(PG8_SB(1, 1), cB + hstep + kstep, voffB);
        PG8_WAIT_V(6); PG8_BAR;
    }
    for (;;) {
        const bool has_next = S.next(ui + 1, nxt);
        const char* nA = has_next ? (const char*)g.A + (size_t)nxt.row0 * K * 2 + (size_t)nxt.k0 * kstep : cA; const char* nB = has_next ? (const char*)g.Bt + (size_t)nxt.pn * tstep + (size_t)nxt.k0 * kstep : cB;
        const int unt = cur.ntk ? cur.ntk : nt;
        const bool full = (cur.nai == 2);
        for (int t = 0; t < unt; t += 2) {
            const bool last = (t == unt - 2);
            const char* a1 = cA + (size_t)(t + 1) * kstep;
            const char* a2 = last ? nA : cA + (size_t)(t + 2) * kstep; const char* b2 = last ? nB : cB + (size_t)(t + 2) * kstep;
            const char* a3 = a2 + kstep; const char* b3 = b2 + kstep;
            if (last && has_next) S.a_ready(nxt);
            if constexpr (SP2) {
            PG8_LDB(B0, 0, 0); PG8_LDB(B1, 0, 1); PG8_SCHED; PG8_LDA(At, 0, 0); PG8_STAGE(PG8_SA(1, 1), a1 + hstep, voffA);
            PG8_WAIT_V(8); PG8_WAIT_L(0); PG8_BAR; if (cur.bjm & 1) PG8_MMA(0, 0, At, B0); if (cur.bjm & 2) PG8_MMA(0, 1, At, B1); PG8_BAR; PG8_SCHED;
            PG8_LDA(At, 0, 1); PG8_STAGE(PG8_SB(0, 0), b2, voffB); PG8_STAGE(PG8_SB(0, 1), b2 + hstep, voffB); PG8_STAGE(PG8_SA(0, 0), a2, voffA);
            PG8_WAIT_V(8); PG8_WAIT_L(0); PG8_BAR; if (full) { PG8_MMA(1, 0, At, B0); PG8_MMA(1, 1, At, B1); } PG8_BAR; PG8_SCHED;
            PG8_LDB(B0, 1, 0); PG8_LDB(B1, 1, 1); PG8_SCHED; PG8_LDA(At, 1, 0); PG8_STAGE(PG8_SA(0, 1), a2 + hstep, voffA);
            PG8_WAIT_V(8); PG8_WAIT_L(0); PG8_BAR; if (cur.bjm & 1) PG8_MMA(0, 0, At, B0); if (cur.bjm & 2) PG8_MMA(0, 1, At, B1); PG8_BAR; PG8_SCHED;
            PG8_LDA(At, 1, 1); PG8_STAGE(PG8_SB(1, 0), b3, voffB); PG8_STAGE(PG8_SB(1, 1), b3 + hstep, voffB); PG8_STAGE(PG8_SA(1, 0), a3, voffA);
            PG8_WAIT_V(8); PG8_WAIT_L(0); PG8_BAR; if (full) { PG8_MMA(1, 0, At, B0); PG8_MMA(1, 1, At, B1); } PG8_BAR; PG8_SCHED;
            } else {
            PG8_LDB(B0, 0, 0); PG8_SCHED; PG8_LDA(At, 0, 0); PG8_STAGE(PG8_SA(1, 1), a1 + hstep, voffA);
            PG8_WAIT_L(8); PG8_BAR; PG8_WAIT_L(0); PG8_MMA(0, 0, At, B0); PG8_BAR; PG8_SCHED;
            PG8_LDB(B1, 0, 1); PG8_STAGE(PG8_SB(0, 0), b2, voffB);
            PG8_BAR; PG8_WAIT_L(0); PG8_MMA(0, 1, At, B1); PG8_BAR;
            PG8_LDA(At, 0, 1); PG8_STAGE(PG8_SA(0, 0), a2, voffA);
            PG8_BAR; PG8_WAIT_L(0); PG8_MMA(1, 0, At, B0); PG8_BAR; PG8_SCHED;
            PG8_STAGE(PG8_SB(0, 1), b2 + hstep, voffB);
            PG8_WAIT_V(6); PG8_BAR; PG8_MMA(1, 1, At, B1); PG8_BAR;
            PG8_LDB(B0, 1, 0); PG8_SCHED; PG8_LDA(At, 1, 0); PG8_STAGE(PG8_SA(0, 1), a2 + hstep, voffA);
            PG8_WAIT_L(8); PG8_BAR; PG8_WAIT_L(0); PG8_MMA(0, 0, At, B0); PG8_BAR; PG8_SCHED;
            PG8_LDB(B1, 1, 1); PG8_STAGE(PG8_SB(1, 0), b3, voffB);
            PG8_BAR; PG8_WAIT_L(0); PG8_MMA(0, 1, At, B1); PG8_BAR;
            PG8_LDA(At, 1, 1); PG8_STAGE(PG8_SA(1, 0), a3, voffA);
            PG8_BAR; PG8_WAIT_L(0); PG8_MMA(1, 0, At, B0); PG8_BAR; PG8_SCHED;
            PG8_STAGE(PG8_SB(1, 1), b3 + hstep, voffB);
            PG8_WAIT_V(6); PG8_BAR; PG8_MMA(1, 1, At, B1); PG8_BAR;
            }
        }
        if constexpr (ALIGN_EPI) { if (wr == 0) PG8_BAR; }
        if constexpr (!Epi::AFTER_DRAIN) { E(acc, cur, wr, wc, fr, fq); S.done(cur); }
        if (!has_next) break;
#pragma unroll
        for (int a = 0; a < 2; ++a)
#pragma unroll
            for (int b = 0; b < 2; ++b)
#pragma unroll
                for (int m = 0; m < 4; ++m)
#pragma unroll
                    for (int n = 0; n < 2; ++n) acc[a][b][m][n] = (f32x4){0.f, 0.f, 0.f, 0.f};
        cur = nxt; cA = nA; cB = nB; ++ui;
        if constexpr (ALIGN_EPI) { if (wr == 1) PG8_BAR; }
    }
    PG8_WAIT_V(0);
    if constexpr (!ALIGN_EPI) { if (wr == 0) PG8_BAR; }
    PG8_BAR;
    if constexpr (Epi::AFTER_DRAIN) { E.fused(acc, cur, wr, wc, fr, fq, lds, wid, lane); S.done(cur); }
#undef PG8_SA
#undef PG8_SB
#undef PG8_STAGE
#undef PG8_LDA
#undef PG8_LDB
#undef PG8_MMA
#undef PG8_WAIT_V
#undef PG8_WAIT_L
#undef PG8_BAR
#undef PG8_SCHED
}
}
constexpr int NWAVES = 8;
constexpr int DM = 1024, NBP = 8, TP = 2048, NBS = 128, TS = 4;
constexpr int MP = NBP * TP, MS = NBS * TS, MTOT = MP + MS;
constexpr int DFF = 2816, NUP = 2 * DFF, CCH = 512, CWID = 31, NH = 4, DKH = 128, QKVD = 1536, HPITCH = 3072, NIN = 3328, PROJ = 3080;
constexpr float LN_EPS = 1e-5f, RMS_EPS = 1e-6f;
constexpr int NCH = NBP * (TP / 64) * NH;

constexpr size_t MiB = 1u << 20;
constexpr size_t WS_CTL = 0, CTL_ZERO_BYTES = MiB / 2;
constexpr size_t WS_ST1 = 65536, WS_ST2 = WS_ST1 + (size_t)MTOT * 8, WS_CSIN = 393216, WS_BWIN = 409600, WS_CSUP2 = 425984, WS_BWUP2 = 450560;
static_assert(WS_ST2 + (size_t)MTOT * 8 <= WS_CSIN && WS_BWUP2 + NUP * 4 <= CTL_ZERO_BYTES, "ctl map");
constexpr size_t WS_WUP1 = 2 * MiB, WS_WDN1 = 13 * MiB, WS_WIN = 18 * MiB + MiB / 2, WS_WOUT = 25 * MiB, WS_WUP2 = 27 * MiB, WS_WDN2 = 38 * MiB;
constexpr size_t WS_H = 44 * MiB, WS_XB = 44 * MiB, WS_HID = 77 * MiB, WS_Z1B = 168 * MiB, WS_PREP = 143 * MiB, WS_MIX = 215 * MiB, WS_GATES = 248 * MiB, WS_EGL = 249 * MiB;
constexpr size_t WS_SLAB1 = 168 * MiB, WS_Z2 = 44 * MiB, WS_SLAB = 77 * MiB, WS_Z2B = 110 * MiB, WS_HID2 = 143 * MiB, WS_END = 250 * MiB;
constexpr size_t PREP_STRIDE = 73728, PREP_W = 0, PREP_QG = 16384, PREP_KDT = 32768, PREP_QK = 49152, PREP_UT = 57344;
static_assert(WS_HID + (size_t)MTOT * DFF * 2 <= WS_Z1B && WS_PREP + (size_t)NCH * PREP_STRIDE <= WS_MIX && WS_HID2 + (size_t)MTOT * DFF * 2 <= WS_END, "ws map");
constexpr int CW_PCNT6 = 87200, CW_UCNT6 = 88300, CW_SCNT6 = 88900;
constexpr int CW_TMO = 0, CW_CODE = 1, CW_BAR = 4096, CW_FLAG = 122880, CW_QCTR = 124928, CW_XCC = 125440, CW_VIOL = 125952;
static_assert((CW_VIOL + 64) * 4 <= (int)CTL_ZERO_BYTES && (size_t)CW_FLAG * 4 >= WS_BWUP2 + (size_t)NUP * 4, "ctl words");
constexpr size_t OUT_Y = 0, OUT_CONVP = (size_t)MTOT * DM, OUT_QKVP = OUT_CONVP + (size_t)NBP * 30 * CCH, OUT_RECP = OUT_QKVP + (size_t)NBP * 3 * QKVD,
                 OUT_CONVS = OUT_RECP + (size_t)NBP * NH * 128 * 128, OUT_QKVS = OUT_CONVS + (size_t)NBS * 30 * CCH, OUT_RECS = OUT_QKVS + (size_t)NBS * 3 * QKVD,
                 OUT_TOTAL = OUT_RECS + (size_t)NBS * NH * 128 * 128;
static_assert(OUT_TOTAL == 28930048, "output size");

constexpr int RING_OFF = 0, RING_BYTES = 131072;
constexpr int LDS_BYTES = 155648;
constexpr int MISC_OFF = LDS_BYTES - 256;

#define GAS __attribute__((address_space(1)))
#define LAS __attribute__((address_space(3)))
typedef unsigned short bf16;
typedef unsigned v4u __attribute__((ext_vector_type(4)));
typedef unsigned v2u __attribute__((ext_vector_type(2)));
typedef float f32x4 __attribute__((ext_vector_type(4)));
typedef float f32x2 __attribute__((ext_vector_type(2)));
typedef short bf16x8 __attribute__((ext_vector_type(8)));
typedef GAS unsigned gu32;
#define RLX_AGENT __ATOMIC_RELAXED, __HIP_MEMORY_SCOPE_AGENT
#define LDS_WAIT() asm volatile("s_waitcnt lgkmcnt(0)" ::: "memory")
#define VM_WAIT() asm volatile("s_waitcnt vmcnt(0)" ::: "memory")
#define LBAR() do { asm volatile("s_waitcnt lgkmcnt(0)" ::: "memory"); __builtin_amdgcn_s_barrier(); asm volatile("" ::: "memory"); } while (0)
__device__ __forceinline__ unsigned f2bf(float f) { unsigned u = __builtin_bit_cast(unsigned, f); return (u + 0x7fffu + ((u >> 16) & 1u)) >> 16; }
typedef __bf16 bf16x2_t __attribute__((ext_vector_type(2)));
__device__ __forceinline__ unsigned pk2(float lo, float hi) { const f32x2 v = {lo, hi}; return __builtin_bit_cast(unsigned, __builtin_convertvector(v, bf16x2_t)); }
__device__ __forceinline__ float bf2f(unsigned h) { return __builtin_bit_cast(float, h << 16); }
__device__ __forceinline__ void unpack8(const v4u w, float* o) {
    o[0] = bf2f(w.x & 0xffffu); o[1] = __builtin_bit_cast(float, w.x & 0xffff0000u); o[2] = bf2f(w.y & 0xffffu); o[3] = __builtin_bit_cast(float, w.y & 0xffff0000u);
    o[4] = bf2f(w.z & 0xffffu); o[5] = __builtin_bit_cast(float, w.z & 0xffff0000u); o[6] = bf2f(w.w & 0xffffu); o[7] = __builtin_bit_cast(float, w.w & 0xffff0000u);
}
__device__ __forceinline__ v4u pack8(const float* v) { v4u w; w.x = pk2(v[0], v[1]); w.y = pk2(v[2], v[3]); w.z = pk2(v[4], v[5]); w.w = pk2(v[6], v[7]); return w; }
__device__ __forceinline__ float sigmoid_f(float x) { return __builtin_amdgcn_rcpf(1.0f + __expf(-x)); }
__device__ __forceinline__ float siluf(float x) { return x * __builtin_amdgcn_rcpf(1.0f + __expf(-x)); }
__device__ __forceinline__ float softplus_f(float x) { return fmaxf(x, 0.f) + log1pf(expf(-fabsf(x))); }
__device__ __forceinline__ float wave_sum(float v) {
#pragma unroll
    for (int o = 1; o < 64; o <<= 1) v += __shfl_xor(v, o);
    return v;
}
__device__ __forceinline__ bf16x8 ldfrag(const LAS bf16* base, int ld, int r0, int k0, int lane) { return *(const LAS bf16x8*)(base + (r0 + (lane & 15)) * ld + k0 + 8 * (lane >> 4)); }
#define MFMA16(a, b, c) __builtin_amdgcn_mfma_f32_16x16x32_bf16((a), (b), (c), 0, 0, 0)

#define XB_TMO      128
#define XB_XCNT(j)  (256  + 64 * (j))
#define XB_XSUB(j)  (1280 + 64 * (j))
#define XB_XGEN(j)  (2304 + 64 * (j))
#define XB_TOP      3328
#define XB_TOPGEN   3392
#define XCD_BAR_WORDS 3456
#define XB_SPIN_CAP (1u << 18)

__device__ __forceinline__ unsigned xb_ld(unsigned* p)              { return __hip_atomic_load(p, __ATOMIC_RELAXED, __HIP_MEMORY_SCOPE_AGENT); }
__device__ __forceinline__ unsigned xb_add(unsigned* p, unsigned v) { return __hip_atomic_fetch_add(p, v, __ATOMIC_RELAXED, __HIP_MEMORY_SCOPE_AGENT); }
__device__ __forceinline__ unsigned xb_xcc_id() { return (unsigned)__builtin_amdgcn_s_getreg((3 << 11) | 20) & 0xFu; }
#define XB_SPIN(cond, bar) do { unsigned _sp = 0; while (cond) { __builtin_amdgcn_s_sleep(1); \
    if ((++_sp & 255u) == 0u) { if (xb_ld(&(bar)[XB_TMO])) break; if (_sp > XB_SPIN_CAP) { atomicAdd(&(bar)[XB_TMO], 1u); break; } } } } while (0)

struct XcdBarrier {
    unsigned* bar; unsigned x;
    volatile LAS unsigned* st;
};

__device__ __forceinline__ XcdBarrier xcd_barrier_post(unsigned* bar, volatile LAS unsigned* st) {
    XcdBarrier b; b.bar = bar; b.x = xb_xcc_id(); b.st = st;
    if (threadIdx.x == 0) (void)xb_add(&bar[XB_XCNT(b.x)], 1u);
    return b;
}
__device__ __forceinline__ void xcd_barrier_complete(unsigned* bar, unsigned x, unsigned& nloc, unsigned& nx) {
    const unsigned G = gridDim.x * gridDim.y * gridDim.z;
    unsigned sum, cnt, mine, sp = 0u;
    for (;;) {
        sum = 0u; cnt = 0u; mine = 0u;
#pragma unroll
        for (unsigned j = 0; j < 16; ++j) { const unsigned c = xb_ld(&bar[XB_XCNT(j)]); sum += c; cnt += (c > 0u) ? 1u : 0u; mine = (j == x) ? c : mine; }
        if (sum == G) break;
        __builtin_amdgcn_s_sleep(1);
        if ((++sp & 255u) == 0u) { if (xb_ld(&bar[XB_TMO])) break; if (sp > XB_SPIN_CAP) { atomicAdd(&bar[XB_TMO], 1u); break; } }
    }
    nloc = mine > 0u ? mine : 1u; nx = cnt > 0u ? cnt : 1u;
}

__device__ __forceinline__ void xcd_barrier(const XcdBarrier& b) {
    asm volatile("s_waitcnt vmcnt(0)" ::: "memory");
    __syncthreads();
    if (threadIdx.x == 0) {
        unsigned* bar = b.bar; const unsigned bx_ = (unsigned)__builtin_amdgcn_readfirstlane((int)xb_xcc_id());
        __builtin_amdgcn_s_waitcnt(0);
        unsigned nloc = b.st[0], nx = b.st[1];
        if (nloc == 0u) { xcd_barrier_complete(bar, bx_, nloc, nx); b.st[0] = nloc; b.st[1] = nx; }
        const unsigned old = xb_add(&bar[XB_XSUB(bx_)], 1u);
        const unsigned gen = old / nloc;
        if (old + 1u == (gen + 1u) * nloc) {
            __builtin_amdgcn_fence(__ATOMIC_RELEASE, "agent");
            asm volatile("s_waitcnt vmcnt(0)" ::: "memory");
            const unsigned og = xb_add(&bar[XB_TOP], 1u);
            const unsigned tg = og / nx;
            if (og + 1u == (tg + 1u) * nx) xb_add(&bar[XB_TOPGEN], 1u);
            else XB_SPIN(xb_ld(&bar[XB_TOPGEN]) == tg, bar);
            __builtin_amdgcn_fence(__ATOMIC_ACQUIRE, "agent");
            xb_add(&bar[XB_XGEN(bx_)], 1u);
            asm volatile("s_waitcnt vmcnt(0)" ::: "memory");
        } else {
            XB_SPIN(xb_ld(&bar[XB_XGEN(bx_)]) == gen, bar);
            __builtin_amdgcn_fence(__ATOMIC_ACQUIRE, "agent");
            asm volatile("s_waitcnt vmcnt(0)" ::: "memory");
        }
    }
    __syncthreads();
}
#define CAS __attribute__((address_space(4)))
__device__ __forceinline__ const float* inp(int k) { const CAS char* p = (const CAS char*)__builtin_amdgcn_kernarg_segment_ptr(); asm volatile("" : "+s"(p)); return *(const float* const CAS*)(p + 8 * k); }
struct Frame {
    LAS unsigned char* lds;
    volatile LAS unsigned* MISC;
    gu32* ctl;
    int tid, lane, wave;
    int vcu, G;
    unsigned char* ws; float* out;
};

__device__ __forceinline__ void p0_item(const float* W, int K, int Nsrc, int src0, int src1, bf16* WT, int dst_row0, int kb, const float* gv, const float* bv, float* cs, float* bw, LAS float* scr, int lane) {
    const int k0 = 64 * kb, kk = lane >> 4, n4 = lane & 15;
    const int sc = (n4 < 8 ? src0 : src1 - 32) + 4 * n4;
    const bool ok = sc + 3 < Nsrc;
    f32x4 v[16];
#pragma unroll
    for (int i = 0; i < 16; ++i) v[i] = ok ? __builtin_nontemporal_load((const f32x4*)(W + (size_t)(k0 + 4 * i + kk) * Nsrc + sc)) : (f32x4){0.f, 0.f, 0.f, 0.f};
#pragma unroll
    for (int i = 0; i < 16; ++i) { const int k = 4 * i + kk; *(LAS f32x4*)(scr + k * 64 + ((n4 ^ ((k >> 3) & 7)) << 2)) = v[i]; }
    LDS_WAIT(); asm volatile("" ::: "memory");
    const int c = lane & 7, nl = lane >> 3;
    float g8[8], b8[8];
#pragma unroll
    for (int i = 0; i < 8; ++i) { g8[i] = gv ? gv[k0 + 8 * c + i] : 1.f; b8[i] = (cs && bv) ? bv[k0 + 8 * c + i] : 0.f; }
#pragma unroll
    for (int j = 0; j < 8; ++j) {
        const int n = 8 * j + nl;
        float w[8], wg[8];
#pragma unroll
        for (int i = 0; i < 8; ++i) { w[i] = scr[(8 * c + i) * 64 + ((((n >> 2) ^ c) << 2) | (n & 3))]; wg[i] = w[i] * g8[i]; }
        const v4u o = pack8(wg);
        *(GAS v4u*)(WT + (size_t)(dst_row0 + n) * K + k0 + 8 * c) = o;
        if (cs) {
            float r[8]; unpack8(o, r);
            float a = 0.f, bsum = 0.f;
#pragma unroll
            for (int i = 0; i < 8; ++i) { a += r[i]; bsum += b8[i] * w[i]; }
            a += __shfl_xor(a, 1); a += __shfl_xor(a, 2); a += __shfl_xor(a, 4);
            bsum += __shfl_xor(bsum, 1); bsum += __shfl_xor(bsum, 2); bsum += __shfl_xor(bsum, 4);
            if (c == 0) { unsafeAtomicAdd(cs + dst_row0 + n, a); unsafeAtomicAdd(bw + dst_row0 + n, bsum); }
        }
    }
    LDS_WAIT(); asm volatile("" ::: "memory");
}
__device__ __forceinline__ int up_src_col(int dst_row0) { const int pn = dst_row0 >> 8, j0 = dst_row0 & 255; return j0 < 128 ? 128 * pn + j0 : DFF + 128 * pn + (j0 - 128); }
__device__ __forceinline__ int in_src_col(int dst_row0) { if (dst_row0 >= 1024) return dst_row0; const int pn = dst_row0 >> 8, j0 = dst_row0 & 255; return j0 < 128 ? 128 * pn + j0 : 512 + 128 * pn + (j0 - 128); }
template <int SET> __device__ __forceinline__ void p0_weights(Frame& F, int gw, int NGW) {
    LAS float* scr = (LAS float*)(F.lds + RING_OFF + F.wave * 16384);
    constexpr int I_UP = (DM / 64) * (NUP / 64), I_DN = (DFF / 64) * (DM / 64), I_IN = (DM / 64) * (NIN / 64), I_OUT = (DM / 64) * (DM / 64);
    constexpr int NITEMS = SET == 0 ? I_UP : (SET == 2 ? I_DN + I_IN + I_OUT : I_UP + I_DN);
    unsigned char* ws = F.ws;
    for (int it = gw; it < NITEMS; it += NGW) {
        int r = it;
        if (SET == 0) {
            const int nb = r % (NUP / 64), kb = r / (NUP / 64); p0_item(inp(5), DM, NUP, up_src_col(64 * nb), up_src_col(64 * nb + 32), (bf16*)(ws + WS_WUP1), 64 * nb, kb, nullptr, nullptr, nullptr, nullptr, scr, F.lane);
        } else if (SET == 2) {
            if (r < I_DN) { const int nb = r % (DM / 64), kb = r / (DM / 64); p0_item(inp(6), DFF, DM, 64 * nb, 64 * nb + 32, (bf16*)(ws + WS_WDN1), 64 * nb, kb, nullptr, nullptr, nullptr, nullptr, scr, F.lane); continue; } r -= I_DN;
            if (r < I_IN) { const int nb = r % (NIN / 64), kb = r / (NIN / 64); p0_item(inp(9), DM, PROJ, in_src_col(64 * nb), in_src_col(64 * nb + 32), (bf16*)(ws + WS_WIN), 64 * nb, kb, inp(7), inp(8), (float*)(ws + WS_CSIN), (float*)(ws + WS_BWIN), scr, F.lane); continue; } r -= I_IN;
            { const int nb = r % (DM / 64), kb = r / (DM / 64); p0_item(inp(18), DM, DM, 64 * nb, 64 * nb + 32, (bf16*)(ws + WS_WOUT), 64 * nb, kb, nullptr, nullptr, nullptr, nullptr, scr, F.lane); }
        } else {
            if (r < I_UP) { const int nb = r % (NUP / 64), kb = r / (NUP / 64); p0_item(inp(21), DM, NUP, up_src_col(64 * nb), up_src_col(64 * nb + 32), (bf16*)(ws + WS_WUP2), 64 * nb, kb, inp(19), inp(20), (float*)(ws + WS_CSUP2), (float*)(ws + WS_BWUP2), scr, F.lane); continue; } r -= I_UP;
            { const int nb = r % (DM / 64), kb = r / (DM / 64); p0_item(inp(22), DFF, DM, 64 * nb, 64 * nb + 32, (bf16*)(ws + WS_WDN2), 64 * nb, kb, nullptr, nullptr, nullptr, nullptr, scr, F.lane); }
        }
    }
}
__device__ __forceinline__ void p0_prologue(Frame& F) {
    const int gw = F.vcu * NWAVES + F.wave, NGW = F.G * NWAVES;
    unsigned char* ws = F.ws;
    p0_weights<0>(F, gw, NGW);
    bf16* xb = (bf16*)(ws + WS_XB);
    for (int m0 = 2 * gw; m0 < MTOT; m0 += 2 * NGW) {
        f32x4 v[2][4];
#pragma unroll
        for (int r2 = 0; r2 < 2; ++r2) { const int m = m0 + r2; const float* xr = (m < MP) ? inp(0) + (size_t)m * DM : inp(1) + (size_t)(m - MP) * DM;
            const GAS f32x4* x4 = (const GAS f32x4*)xr + F.lane;
#pragma unroll
            for (int j = 0; j < 4; ++j) v[r2][j] = __builtin_nontemporal_load((const f32x4*)x4 + 64 * j); }
#pragma unroll
        for (int r2 = 0; r2 < 2; ++r2) { GAS v2u* o8 = (GAS v2u*)(xb + (size_t)(m0 + r2) * DM) + F.lane;
#pragma unroll
            for (int j = 0; j < 4; ++j) { v2u w; w.x = pk2(v[r2][j].x, v[r2][j].y); w.y = pk2(v[r2][j].z, v[r2][j].w); o8[64 * j] = w; } }
    }
}

__host__ __device__ constexpr int swap23(int k) { return (k & ~12) | ((k & 4) << 1) | ((k & 8) >> 1); }
__host__ __device__ constexpr int ut_tok(int P) { return (P & ~31) | (P & 3) | (((P >> 4) & 1) << 2) | (((P >> 2) & 3) << 3); }
constexpr int AMP = 68;
constexpr int P4_QN = 0, P4_KN = 17408, P4_KB = 34816, P4_RHS = 52224, P4_AM = 117760, P4_GC = 135168, P4_CW = 145152;
__device__ __forceinline__ int p4_flag_index(int ch) { return (((ch >> 7) * 4 + (ch & 3)) << 5) + ((ch >> 2) & 31); }
__device__ __forceinline__ void p4_run(Frame& F, const int ch0, const int stride, const int nit, const bool publish) {
    LAS bf16* Qn = (LAS bf16*)(F.lds + P4_QN); LAS bf16* Kn = (LAS bf16*)(F.lds + P4_KN); LAS bf16* KB = (LAS bf16*)(F.lds + P4_KB);
    LAS float* RHS = (LAS float*)(F.lds + P4_RHS); LAS float* AM = (LAS float*)(F.lds + P4_AM); LAS float* GC = (LAS float*)(F.lds + P4_GC); LAS float* BT = GC + 64; LAS float* ED = GC + 128;
    LAS bf16* AB = (LAS bf16*)(F.lds + P4_GC + 768);
    LAS bf16* XT = (LAS bf16*)(F.lds + 0);
    LAS float* CW = (LAS float*)(F.lds + P4_CW);
    const bf16* H = (const bf16*)(F.ws + WS_H); const float* gates = (const float*)(F.ws + WS_GATES);
    if (nit <= 0) return;
    const bool same_head = (stride & 3) == 0;
    v4u nx[3][4]; float nvm[4]; float gbl = 0.f, gal = 0.f;
#define P4_LOADROWS(CH, PASS) do { const int hh_ = (CH) & 3, n_ = ((CH) >> 2) & 31, b_ = (CH) >> 7; const int t_ = (ftid >> 4) + 32 * (PASS), c0_ = (ftid & 15) * 8, tt_ = n_ * 64 + t_; \
        _Pragma("unroll") for (int i = 0; i < 4; ++i) { const int r = tt_ - 3 + i; const int rc = r < 0 ? 0 : r; nvm[i] = r < 0 ? 0.f : 1.f;     \
            _Pragma("unroll") for (int X = 0; X < 3; ++X) nx[X][i] = *(const v4u*)(H + ((size_t)b_ * TP + rc) * HPITCH + 1024 + X * 512 + hh_ * 128 + c0_); } } while (0)
#define P4_LOADGATES(CH) do { const int hh_ = (CH) & 3, n_ = ((CH) >> 2) & 31, b_ = (CH) >> 7; if (wv == 0) { const size_t m_ = (size_t)b_ * TP + n_ * 64 + ftid; gbl = gates[m_ * 8 + hh_]; gal = gates[m_ * 8 + 4 + hh_]; } } while (0)
#define P4_STAGECW(HH) do { const int cwi = ftid / 96, cwr = ftid % 96; \
        if (wv < 6) *(LAS f32x4*)(CW + cwi * 384 + (cwr >> 5) * 128 + 4 * (cwr & 31)) = *(const f32x4*)(inp(14) + (size_t)cwi * QKVD + (cwr >> 5) * 512 + (HH) * 128 + 4 * (cwr & 31)); } while (0)
    { int tq_ = threadIdx.x; asm volatile("" : "+v"(tq_)); const int ftid = tq_, wv = __builtin_amdgcn_readfirstlane(tq_ >> 6);
      P4_LOADROWS(ch0, 0); P4_LOADGATES(ch0);
      if (same_head) { P4_STAGECW(ch0 & 3); LBAR(); } }
#pragma unroll 1
  for (int it = 0; it < nit; ++it) {
    int ch_ = ch0 + it * stride, chn_ = (it + 1 < nit) ? ch_ + stride : ch_;
    asm volatile("" : "+s"(ch_), "+s"(chn_));
    const int ch = ch_, chn = chn_;
    const int hh = ch & 3, n = (ch >> 2) & 31, b = ch >> 7;
    unsigned char* pb = F.ws + WS_PREP + (size_t)ch * PREP_STRIDE;
    bf16* Wg = (bf16*)(pb + PREP_W); bf16* QGg = (bf16*)(pb + PREP_QG); bf16* KDTg = (bf16*)(pb + PREP_KDT); bf16* QKg = (bf16*)(pb + PREP_QK); bf16* UTg = (bf16*)(pb + PREP_UT);
    int tq_ = threadIdx.x; asm volatile("" : "+v"(tq_));
    const int lane = tq_ & 63, ftid = tq_, wv = __builtin_amdgcn_readfirstlane(tq_ >> 6);
    if (!same_head) { P4_STAGECW(hh); LBAR(); }
    if (wv == 0) {
        const int t = ftid;
        BT[t] = sigmoid_f(gbl);
        float v = -expf(inp(15)[hh]) * softplus_f(gal + inp(16)[hh]);
#pragma unroll
        for (int o = 1; o < 64; o <<= 1) { const float u = __shfl_up(v, o); if (lane >= o) v += u; }
        GC[t] = v;
        ED[t] = expf(__shfl(v, 63) - v);
    }
    float gl = 0.f;
#pragma unroll 1
    for (int pass = 0; pass < 2; ++pass) {
        int tid_ = ftid; asm volatile("" : "+v"(tid_));
        const int tid = tid_, t = (tid >> 4) + 32 * pass, cg = tid & 15, c0 = cg * 8;
        const int tt = n * 64 + t;
        float xq[3][8];
        v4u rawp[3][4]; float vm[4];
#pragma unroll
        for (int i = 0; i < 4; ++i) { vm[i] = nvm[i];
#pragma unroll
            for (int X = 0; X < 3; ++X) rawp[X][i] = nx[X][i]; }
        asm volatile("" : "+v"(rawp[0][0].x), "+v"(rawp[1][0].x), "+v"(rawp[2][0].x));
        asm volatile("" : "+v"(rawp[0][3].w), "+v"(rawp[1][3].w), "+v"(rawp[2][3].w));
        if (pass == 0) P4_LOADROWS(ch, 1);
        else if (publish) VM_WAIT();
        if (n == 0) {
#pragma unroll
            for (int i = 0; i < 4; ++i)
#pragma unroll
                for (int X = 0; X < 3; ++X) if (vm[i] == 0.f) rawp[X][i] = (v4u){0u, 0u, 0u, 0u};
        }
#pragma unroll
        for (int X = 0; X < 3; ++X) {
            const int col = X * 512 + hh * 128 + c0;
            f32x4 wv[4][2];
#pragma unroll
            for (int i = 0; i < 4; ++i) { const LAS f32x4* wp = (const LAS f32x4*)(CW + i * 384 + X * 128 + c0); wv[i][0] = wp[0]; wv[i][1] = wp[1]; }
            float acc[8];
#pragma unroll
            for (int c = 0; c < 8; ++c) acc[c] = 0.f;
#pragma unroll
            for (int i = 0; i < 4; ++i) {
                float raw[8]; unpack8(rawp[X][i], raw);
#pragma unroll
                for (int e = 0; e < 4; ++e) { acc[e] += wv[i][0][e] * raw[e]; acc[4 + e] += wv[i][1][e] * raw[4 + e]; }
            }
#pragma unroll
            for (int c = 0; c < 8; ++c) xq[X][c] = siluf(acc[c]);
        }
        float sq = 0.f, sk = 0.f;
#pragma unroll
        for (int c = 0; c < 8; ++c) { sq += xq[0][c] * xq[0][c]; sk += xq[1][c] * xq[1][c]; }
        sq += __shfl_xor(sq, 1); sq += __shfl_xor(sq, 2); sq += __shfl_xor(sq, 4); sq += __shfl_xor(sq, 8);
        sk += __shfl_xor(sk, 1); sk += __shfl_xor(sk, 2); sk += __shfl_xor(sk, 4); sk += __shfl_xor(sk, 8);
        const float rq = rsqrtf(sq + RMS_EPS) * 0.08838834764831845f, rk = rsqrtf(sk + RMS_EPS);
        if (pass == 0) { LBAR(); gl = GC[63]; }
        const float beta = BT[t], gc = GC[t], eg = expf(gc);
        float q[8], k[8], kb[8], qg[8];
#pragma unroll
        for (int c = 0; c < 8; ++c) { q[c] = xq[0][c] * rq; k[c] = xq[1][c] * rk; kb[c] = k[c] * beta; qg[c] = q[c] * eg; }
        *(LAS v4u*)(Qn + t * 136 + c0) = pack8(q); *(LAS v4u*)(Kn + t * 136 + c0) = pack8(k); *(LAS v4u*)(KB + t * 136 + c0) = pack8(kb);
        { v2u lo, hi; lo.x = pk2(qg[0], qg[1]); lo.y = pk2(qg[2], qg[3]); hi.x = pk2(qg[4], qg[5]); hi.y = pk2(qg[6], qg[7]);
          bf16* qp = QGg + t * 128 + (c0 & ~15) + 4 * (cg & 1); *(v2u*)qp = lo; *(v2u*)(qp + 8) = hi; }
        { LAS f32x4* rp = (LAS f32x4*)(RHS + t * 256 + c0);
          rp[0] = (f32x4){xq[2][0] * beta, xq[2][1] * beta, xq[2][2] * beta, xq[2][3] * beta}; rp[1] = (f32x4){xq[2][4] * beta, xq[2][5] * beta, xq[2][6] * beta, xq[2][7] * beta};
          rp[32] = (f32x4){kb[0] * eg, kb[1] * eg, kb[2] * eg, kb[3] * eg}; rp[33] = (f32x4){kb[4] * eg, kb[5] * eg, kb[6] * eg, kb[7] * eg}; }
        if (n == 31 && t == 63) {
            for (int X = 0; X < 3; ++X)
                for (int j = 0; j < 3; ++j) { float* o = F.out + OUT_QKVP + ((size_t)b * 3 + j) * QKVD + X * 512 + hh * 128 + c0;
                    const bf16* p = H + ((size_t)b * TP + (TP - 3 + j)) * HPITCH + 1024 + X * 512 + hh * 128 + c0;
                    for (int c = 0; c < 8; ++c) o[c] = bf2f(p[c]); }
        }
    }
    if (ftid == 0) ((float*)(F.ws + WS_EGL))[ch * 32] = expf(gl);
    LBAR();
    if (publish && it > 0 && ftid == 511) __hip_atomic_store((unsigned*)(F.ctl + CW_FLAG) + p4_flag_index(ch - stride), 1u, RLX_AGENT);
    {
        const int dk = ftid & 127, pg = ftid >> 7;
#pragma unroll
        for (int g2 = 0; g2 < 2; ++g2) {
            const int p0 = 8 * (2 * pg + g2); float kv[8];
#pragma unroll
            for (int e = 0; e < 8; ++e) { const int tok = swap23(p0 + e); kv[e] = bf2f(Kn[tok * 136 + dk]) * ED[tok]; }
            *(v4u*)(KDTg + dk * 64 + p0) = pack8(kv);
        }
    }
    {
        const int p = wv >> 2, tm = wv & 3, q4 = lane >> 4, jl = lane & 15;
        const LAS bf16* Ab = p ? Qn : KB;
        bf16x8 af[4];
#pragma unroll
        for (int ks = 0; ks < 4; ++ks) af[ks] = ldfrag(Ab, 136, tm * 16, ks * 32, lane);
        const int i = tm * 16 + jl; const float gi = GC[i];
#pragma unroll
        for (int tn = 0; tn < 4; ++tn) {
            f32x4 acc = {0.f, 0.f, 0.f, 0.f};
            bf16x8 kf[4];
#pragma unroll
            for (int ks = 0; ks < 4; ++ks) kf[ks] = ldfrag(Kn, 136, tn * 16, ks * 32, lane);
#pragma unroll
            for (int ks = 0; ks < 4; ++ks) acc = MFMA16(kf[ks], af[ks], acc);
            const int j0 = tn * 16 + 4 * q4; const f32x4 gj = *(const LAS f32x4*)(GC + j0);
            float a_[4];
#pragma unroll
            for (int r = 0; r < 4; ++r) { const float d = __expf(gi - gj[r]); a_[r] = (i + p > j0 + r) ? acc[r] * d : 0.f; }
            v2u pk; pk.x = pk2(a_[0], a_[1]); pk.y = pk2(a_[2], a_[3]);
            if (p == 0) { *(LAS f32x4*)(AM + i * AMP + j0) = (f32x4){a_[0], a_[1], a_[2], a_[3]}; *(LAS v2u*)(AB + i * 72 + j0) = pk; }
            else *(v2u*)(QKg + i * 64 + tn * 16 + 4 * (((q4 & 1) << 1) | (q4 >> 1))) = pk;
        }
    }
    LBAR();
    P4_LOADROWS(chn, 0); P4_LOADGATES(chn);
    { unsigned zz = 0u; asm volatile("" : "+v"(zz));
      for (int i = ftid; i < 256 * 72 / 8; i += 512) *(LAS v4u*)(XT + i * 8) = (v4u){zz, zz, zz, zz}; }
    LBAR();
    {
        const int c = wv * 64 + lane;
        const LAS float* AMb = AM; const LAS float* Rb = RHS + c;
        asm volatile("" : "+v"(AMb), "+v"(Rb));
#pragma unroll
        for (int r = 0; r < 4; ++r) {
            if (r > 0) {
                const int q4 = lane >> 4, jl = lane & 15;
#pragma unroll
                for (int t2 = 0; t2 < 2; ++t2) {
                    const int ct = wv * 2 + t2;
                    f32x4 acc = {0.f, 0.f, 0.f, 0.f};
#pragma unroll
                    for (int ks = 0; ks < (r + 1) / 2; ++ks) acc = MFMA16(ldfrag(AB, 72, 16 * r, ks * 32, lane), ldfrag(XT, 72, ct * 16, ks * 32, lane), acc);
#pragma unroll
                    for (int e = 0; e < 4; ++e) RHS[(16 * r + 4 * q4 + e) * 256 + ct * 16 + jl] -= acc[e];
                }
                LBAR();
            }
            if (wv < 4) {
                float rh[16];
#pragma unroll
                for (int i = 0; i < 16; ++i) rh[i] = Rb[(16 * r + i) * 256];
                f32x2 s2[8];
#pragma unroll
                for (int k = 0; k < 8; ++k) s2[k] = (f32x2){0.f, 0.f};
                f32x4 an[4];
                an[0] = *(const LAS f32x4*)(AMb + (16 * r + 1) * AMP + 16 * r);
                s2[0].x = rh[0];
#pragma unroll
                for (int i = 1; i < 16; ++i) {
                    f32x4 ac[4];
#pragma unroll
                    for (int j4 = 0; j4 < (i + 3) / 4; ++j4) ac[j4] = an[j4];
                    if (i + 1 < 16) {
#pragma unroll
                        for (int j4 = 0; j4 < (i + 4) / 4; ++j4) an[j4] = *(const LAS f32x4*)(AMb + (16 * r + i + 1) * AMP + 16 * r + 4 * j4);
                    }
                    f32x2 va = {rh[i], 0.f}, vb = {0.f, 0.f};
#pragma unroll
                    for (int j4 = 0; j4 < (i + 3) / 4; ++j4) { va -= ac[j4].xy * s2[2 * j4]; vb -= ac[j4].zw * s2[2 * j4 + 1]; }
                    const f32x2 t = va + vb; const float si = t.x + t.y;
                    if (i & 1) s2[i >> 1].y = si; else s2[i >> 1].x = si;
                }
                { v4u w0, w1; w0.x = pk2(s2[0].x, s2[0].y); w0.y = pk2(s2[1].x, s2[1].y); w0.z = pk2(s2[2].x, s2[2].y); w0.w = pk2(s2[3].x, s2[3].y);
                  w1.x = pk2(s2[4].x, s2[4].y); w1.y = pk2(s2[5].x, s2[5].y); w1.z = pk2(s2[6].x, s2[6].y); w1.w = pk2(s2[7].x, s2[7].y);
                  *(LAS v4u*)(XT + c * 72 + 16 * r) = w0; *(LAS v4u*)(XT + c * 72 + 16 * r + 8) = w1; }
            }
            LBAR();
        }
    }
    {
        const int c = ftid >> 2;
#pragma unroll
        for (int h2 = 0; h2 < 2; ++h2) {
            const int i8 = 2 * (ftid & 3) + h2, base = 32 * (i8 >> 2) + 4 * ((i8 >> 1) & 1);
            const v2u lo = *(const LAS v2u*)(XT + c * 72 + base + 8 * ((2 * i8) & 3)), hi = *(const LAS v2u*)(XT + c * 72 + base + 8 * ((2 * i8 + 1) & 3));
            *(v4u*)(UTg + c * 64 + 8 * i8) = (v4u){lo.x, lo.y, hi.x, hi.y};
        }
        const int i = ftid >> 3, p0 = 16 * (ftid & 7);
#pragma unroll
        for (int h2 = 0; h2 < 2; ++h2) {
            unsigned w[4];
#pragma unroll
            for (int e2 = 0; e2 < 4; ++e2) {
                const unsigned a0 = XT[(128 + swap23(p0 + 8 * h2 + 2 * e2)) * 72 + i], a1 = XT[(128 + swap23(p0 + 8 * h2 + 2 * e2 + 1)) * 72 + i];
                w[e2] = a0 | (a1 << 16);
            }
            *(v4u*)(Wg + i * 128 + p0 + 8 * h2) = (v4u){w[0], w[1], w[2], w[3]};
        }
    }
    LBAR();
    if (publish && it <= 1 && it + 1 < nit) {
        VM_WAIT(); LBAR();
        if (ftid == 511) __hip_atomic_store((unsigned*)(F.ctl + CW_FLAG) + p4_flag_index(ch), 1u, RLX_AGENT);
    }
  }
  if (publish) {
    __syncthreads();
    if (threadIdx.x == 0) { __hip_atomic_store((unsigned*)(F.ctl + CW_FLAG) + p4_flag_index(ch0 + (nit - 1) * stride), 1u, RLX_AGENT); }
  }
}

constexpr int S5_OPB = 57344, S5_OW = 0, S5_OQG = 16384, S5_OKD = 32768, S5_OQK = 49152, S5_OX = 2 * S5_OPB, S5_OXB = 64 * 272, S5_GN = S5_OX + 2 * S5_OXB;
typedef float f32x16 __attribute__((ext_vector_type(16)));
#define MFMA32(a, b, c) __builtin_amdgcn_mfma_f32_32x32x16_bf16((a), (b), (c), 0, 0, 0)
__device__ __forceinline__ bf16x8 ldf256(const LAS unsigned char* base, int row, int chunk) { return *(const LAS bf16x8*)(base + row * 256 + ((chunk ^ (row & 15)) << 4)); }
__device__ __forceinline__ bf16x8 ldf128(const LAS unsigned char* base, int row, int chunk) { return *(const LAS bf16x8*)(base + row * 128 + ((chunk ^ ((row >> 1) & 7)) << 4)); }
__device__ __forceinline__ bf16x8 cvt8(const f32x16& x, int b) {
    v4u w; w.x = pk2(x[8 * b + 0], x[8 * b + 1]); w.y = pk2(x[8 * b + 2], x[8 * b + 3]); w.z = pk2(x[8 * b + 4], x[8 * b + 5]); w.w = pk2(x[8 * b + 6], x[8 * b + 7]);
    return __builtin_bit_cast(bf16x8, w);
}
struct ScanStage { v4u r[12]; };
struct ScanQK { v4u r[2]; };
struct ZSt { v4u z[4]; };
__device__ __forceinline__ void scan_stage_load(ScanStage& st, const unsigned char* pb, int ht) {
#pragma unroll
    for (int i = 0; i < 12; ++i) st.r[i] = __builtin_nontemporal_load((const v4u*)(pb + (size_t)(ht + 256 * i) * 16));
}
__device__ __forceinline__ void scan_qk_load(ScanQK& st, const unsigned char* pb, int ht) {
#pragma unroll
    for (int i = 0; i < 2; ++i) st.r[i] = __builtin_nontemporal_load((const v4u*)(pb + (size_t)(ht + 256 * (12 + i)) * 16));
}
__device__ __forceinline__ int scan_stage_off(int ht, int i) {
    const int p = ht + 256 * i;
    if (i < 8) { const int q = p & 1023, row = q >> 4, ch = q & 15; return (i < 4 ? S5_OW : S5_OQG) + row * 256 + ((ch ^ (row & 15)) << 4); }
    const int q = (i < 12) ? (p - 2048) : (p - 3072), row = q >> 3, ch = q & 7; return (i < 12 ? S5_OKD : S5_OQK) + row * 128 + ((ch ^ ((row >> 1) & 7)) << 4);
}
__device__ __forceinline__ void scan_stage_store(const ScanStage& st, const ScanQK& qk, LAS unsigned char* ob, int ht) {
#pragma unroll
    for (int i = 0; i < 12; ++i) { *(LAS v4u*)(ob + scan_stage_off(ht, i)) = st.r[i]; asm volatile("" ::: "memory"); }
#pragma unroll
    for (int i = 0; i < 2; ++i) { *(LAS v4u*)(ob + scan_stage_off(ht, 12 + i)) = qk.r[i]; asm volatile("" ::: "memory"); }
}
__device__ __forceinline__ unsigned scan_flag_ld(const unsigned* p) { return __hip_atomic_load(p, __ATOMIC_RELAXED, __HIP_MEMORY_SCOPE_AGENT); }
__device__ __forceinline__ void p5_scan(Frame& F, int bh, const bool waitf) {
    const int b = bh >> 2, hh = bh & 3;
    const unsigned* flg = (const unsigned*)(F.ctl + CW_FLAG) + bh * 32;
    if (waitf) {
        while ((scan_flag_ld(flg) & scan_flag_ld(flg + 1) & scan_flag_ld(flg + 2)) == 0u) __builtin_amdgcn_s_sleep(16);
        __builtin_amdgcn_fence(__ATOMIC_ACQUIRE, "agent");
    }
    const bf16* H = (const bf16*)(F.ws + WS_H); bf16* MIX = (bf16*)(F.ws + WS_MIX); const float* EGL = (const float*)(F.ws + WS_EGL);
    const unsigned char* prep0 = F.ws + WS_PREP + (size_t)((b * 32) * 4 + hh) * PREP_STRIDE;
    const int tid = F.tid, lane = F.lane, w = F.wave;
#ifndef SCAN_NO_C
    if (w < 4) {
        int lnp_ = threadIdx.x; asm volatile("" : "+v"(lnp_)); lnp_ &= 63;
        const int c = lnp_ & 31, h = lnp_ >> 5, dv = 32 * w + c;
        f32x16 S[4];
#pragma unroll
        for (int i = 0; i < 4; ++i)
#pragma unroll
            for (int g = 0; g < 16; ++g) S[i][g] = 0.f;
        int fo256[8], fo128[4];
#pragma unroll
        for (int s = 0; s < 8; ++s) fo256[s] = c * 256 + (((2 * s + h) ^ (c & 15)) << 4);
#pragma unroll
        for (int s = 0; s < 4; ++s) fo128[s] = c * 128 + (((2 * s + h) ^ ((c >> 1) & 7)) << 4);
        v4u ua[4], ub[4]; float ega, egb;
#define SCAN_ULOAD(U, EG, NCH) do { const int nc_ = (NCH) < 32 ? (NCH) : 31; const v4u* up = (const v4u*)(prep0 + (size_t)nc_ * 4 * PREP_STRIDE + PREP_UT + (size_t)dv * 128); \
            U[0] = __builtin_nontemporal_load(up + 2 * h); U[1] = __builtin_nontemporal_load(up + 2 * h + 1); U[2] = __builtin_nontemporal_load(up + 4 + 2 * h); U[3] = __builtin_nontemporal_load(up + 4 + 2 * h + 1); \
            EG = EGL[((b * 32 + nc_) * 4 + hh) * 32]; } while (0)
        SCAN_ULOAD(ua, ega, 0); SCAN_ULOAD(ub, egb, 1);
        LBAR();
#define SCAN_CHUNK(N, U, EG) do { \
            int ln_ = threadIdx.x; asm volatile("" : "+v"(ln_)); ln_ &= 63;     \
            const int c = ln_ & 31, h = ln_ >> 5, dv = 32 * w + c; \
            int vb256[8], vb128[4];                            \
            _Pragma("unroll") for (int s = 0; s < 8; ++s) { vb256[s] = fo256[s] + ((N) & 1) * S5_OPB; asm volatile("" : "+v"(vb256[s])); } \
            _Pragma("unroll") for (int s = 0; s < 4; ++s) { vb128[s] = fo128[s] + ((N) & 1) * S5_OPB; asm volatile("" : "+v"(vb128[s])); } \
            asm volatile("" : "+v"(U[0].x), "+v"(U[0].y), "+v"(U[0].z), "+v"(U[0].w), "+v"(U[1].x), "+v"(U[1].y), "+v"(U[1].z), "+v"(U[1].w)); \
            asm volatile("" : "+v"(U[2].x), "+v"(U[2].y), "+v"(U[2].z), "+v"(U[2].w), "+v"(U[3].x), "+v"(U[3].y), "+v"(U[3].z), "+v"(U[3].w), "+v"(EG)); \
            const float eg = EG; \
              \
            bf16x8 bS[8]; \
            _Pragma("unroll") for (int s = 0; s < 8; ++s) bS[s] = cvt8(S[s >> 1], s & 1); \
              \
            bf16x8 bV[4]; \
            _Pragma("unroll") for (int tt = 0; tt < 2; ++tt) { \
                bf16x8 fw[8]; \
                _Pragma("unroll") for (int s = 0; s < 8; ++s) fw[s] = LDF256(S5_OW, tt, s); \
                f32x16 a; \
                _Pragma("unroll") for (int g = 0; g < 16; ++g) a[g] = 0.f; \
                _Pragma("unroll") for (int s = 0; s < 8; ++s) a = MFMA32(fw[s], bS[s], a); \
                float u[16]; unpack8(U[2 * tt], u); unpack8(U[2 * tt + 1], u + 8); \
                _Pragma("unroll") for (int g = 0; g < 16; ++g) a[g] = u[g] - a[g]; \
                bV[2 * tt] = cvt8(a, 0); bV[2 * tt + 1] = cvt8(a, 1); \
            } \
            SCAN_ULOAD(U, EG, (N) + 2);                         \
              \
            LAS unsigned char* ox = F.lds + S5_OX + ((N) & 1) * S5_OXB; \
            _Pragma("unroll") for (int tt = 0; tt < 2; ++tt) { \
                f32x16 o; \
                _Pragma("unroll") for (int g = 0; g < 16; ++g) o[g] = 0.f; \
                { bf16x8 fq[8]; \
                  _Pragma("unroll") for (int s = 0; s < 8; ++s) fq[s] = LDF256(S5_OQG, tt, s); \
                  _Pragma("unroll") for (int s = 0; s < 8; ++s) o = MFMA32(bS[s], fq[s], o); } \
                { bf16x8 fk[4]; \
                  _Pragma("unroll") for (int s = 0; s < 4; ++s) fk[s] = LDF128(S5_OQK, tt, s); \
                  _Pragma("unroll") for (int s = 0; s < 4; ++s) o = MFMA32(bV[s], fk[s], o); } \
                  \
                _Pragma("unroll") for (int a4 = 0; a4 < 4; ++a4) { v2u pk; pk.x = pk2(o[4 * a4], o[4 * a4 + 1]); pk.y = pk2(o[4 * a4 + 2], o[4 * a4 + 3]); \
                    *(LAS v2u*)(ox + (32 * tt + c) * 272 + (32 * w + 8 * a4 + 4 * h) * 2) = pk; } \
            } \
              \
            _Pragma("unroll") for (int d = 0; d < 4; ++d) { \
                bf16x8 fd[4]; \
                _Pragma("unroll") for (int s = 0; s < 4; ++s) fd[s] = LDF128(S5_OKD, d, s); \
                f32x16 sacc = S[d] * eg; \
                _Pragma("unroll") for (int s = 0; s < 4; ++s) sacc = MFMA32(fd[s], bV[s], sacc); \
                S[d] = sacc; \
            } \
            LBAR(); } while (0)
#define LDF256(MAT, TT, S_) (*(const LAS bf16x8*)(F.lds + vb256[S_] + ((MAT) + (TT) * 8192)))
#define LDF128(MAT, TT, S_) (*(const LAS bf16x8*)(F.lds + vb128[S_] + ((MAT) + (TT) * 4096)))
#pragma unroll 1
        for (int n = 0; n < 32; n += 2) { SCAN_CHUNK(n, ua, ega); SCAN_CHUNK(n + 1, ub, egb); }
#undef SCAN_CHUNK
#undef SCAN_ULOAD
        LBAR();
        { int le_ = threadIdx.x; asm volatile("" : "+v"(le_));
          const int c = le_ & 31, h = (le_ >> 5) & 1, dv = 32 * w + c;
          float* RS = F.out + OUT_RECP + (size_t)bh * 128 * 128;
#pragma unroll
          for (int d = 0; d < 4; ++d)
#pragma unroll
              for (int g = 0; g < 16; ++g) RS[(size_t)(32 * d + (g & 3) + 8 * (g >> 2) + 4 * h) * 128 + dv] = S[d][g]; }
    }
#endif
#ifndef SCAN_NO_H
    if (w >= 4) {
        int htp_ = threadIdx.x; asm volatile("" : "+v"(htp_)); htp_ -= 256;
        const int ht = htp_, t = ht >> 2, q = ht & 3;
        const bf16* zbase = H + ((size_t)b * TP + t) * HPITCH + 2560 + hh * 128 + 32 * q;
        bf16* obase = MIX + ((size_t)b * TP + t) * DM + 512 + hh * 128 + 32 * q;
        ScanStage sa, sb, sc; ScanQK qa, qb;
        unsigned fl = 1u;
        if (waitf) fl = scan_flag_ld(flg + 3 + (htp_ >> 20));
        scan_stage_load(sa, prep0, ht); scan_qk_load(qa, prep0, ht);
        scan_stage_store(sa, qa, F.lds, ht);
        scan_stage_load(sb, prep0 + (size_t)4 * PREP_STRIDE, ht); scan_qk_load(qb, prep0 + (size_t)4 * PREP_STRIDE, ht);
        scan_stage_load(sc, prep0 + (size_t)8 * PREP_STRIDE, ht);
        LBAR();
#define SCAN_GATE(ZST, NCH) do { \
            const LAS unsigned char* oxr = F.lds + S5_OX + ((NCH) & 1) * S5_OXB + t * 272 + q * 64; \
            float ss = 0.f; \
            _Pragma("unroll") for (int i = 0; i < 4; ++i) { float o[8]; unpack8(*(const LAS v4u*)(oxr + 16 * i), o); \
                _Pragma("unroll") for (int e = 0; e < 8; ++e) ss += o[e] * o[e]; } \
            ss += __shfl_xor(ss, 1); ss += __shfl_xor(ss, 2); \
            const float rms = rsqrtf(ss * (1.0f / 128.0f) + RMS_EPS); \
            v4u* op = (v4u*)(obase + (size_t)(NCH) * 64 * DM); \
            _Pragma("unroll") for (int i = 0; i < 4; ++i) { float o[8], z[8], r[8]; unpack8(*(const LAS v4u*)(oxr + 16 * i), o); unpack8((ZST).z[i], z);     \
                _Pragma("unroll") for (int e = 0; e < 8; ++e) r[e] = o[e] * rms * z[e]; \
                op[i] = pack8(r); asm volatile("" ::: "memory"); } } while (0)
        ZSt zcur;
#pragma unroll
        for (int i = 0; i < 4; ++i) zcur.z[i] = (v4u){0u, 0u, 0u, 0u};
#define SCAN_PERIOD(N, X, Y, QX, QY) do { \
            int ht_ = htp_; asm volatile("" : "+v"(ht_));        \
            const int ht = ht_, t = ht >> 2, q = ht & 3; \
            const bf16* zbase = H + ((size_t)b * TP + t) * HPITCH + 2560 + hh * 128 + 32 * q; \
            bf16* obase = MIX + ((size_t)b * TP + t) * DM + 512 + hh * 128 + 32 * q; \
            asm volatile("" : "+v"(zcur.z[0].x), "+v"(zcur.z[0].y), "+v"(zcur.z[0].z), "+v"(zcur.z[0].w), "+v"(zcur.z[1].x), "+v"(zcur.z[1].y), "+v"(zcur.z[1].z), "+v"(zcur.z[1].w)); \
            asm volatile("" : "+v"(zcur.z[2].x), "+v"(zcur.z[2].y), "+v"(zcur.z[2].z), "+v"(zcur.z[2].w), "+v"(zcur.z[3].x), "+v"(zcur.z[3].y), "+v"(zcur.z[3].z), "+v"(zcur.z[3].w)); \
            { const int n3 = (N) + 3 < 32 ? (N) + 3 : 31, n4 = (N) + 4 < 32 ? (N) + 4 : 31; \
              if (waitf) { if (fl == 0u) { while (scan_flag_ld(flg + n3) == 0u) __builtin_amdgcn_s_sleep(8); __builtin_amdgcn_fence(__ATOMIC_ACQUIRE, "agent"); } \
                           fl = scan_flag_ld(flg + n4 + (ht_ >> 20)); } }                      \
            ZSt znext;                                        \
            _Pragma("unroll") for (int i = 0; i < 4; ++i) znext.z[i] = ((const v4u*)(zbase + (size_t)(N) * 64 * HPITCH))[i]; \
            { const int n3 = (N) + 3 < 32 ? (N) + 3 : 31, n2 = (N) + 2 < 32 ? (N) + 2 : 31; scan_stage_load(X, prep0 + (size_t)n3 * 4 * PREP_STRIDE, ht); scan_qk_load(QX, prep0 + (size_t)n2 * 4 * PREP_STRIDE, ht); } \
            if ((N) >= 1) SCAN_GATE(zcur, (N) - 1); \
            scan_stage_store(Y, QY, F.lds + (((N) + 1) & 1) * S5_OPB, ht); \
            LBAR(); \
            _Pragma("unroll") for (int i = 0; i < 4; ++i) zcur.z[i] = znext.z[i]; } while (0)
#pragma unroll 1
        for (int n = 0; n < 30; n += 6) {
            SCAN_PERIOD(n, sa, sb, qa, qb); SCAN_PERIOD(n + 1, sb, sc, qb, qa); SCAN_PERIOD(n + 2, sc, sa, qa, qb); SCAN_PERIOD(n + 3, sa, sb, qb, qa); SCAN_PERIOD(n + 4, sb, sc, qa, qb); SCAN_PERIOD(n + 5, sc, sa, qb, qa); }
        SCAN_PERIOD(30, sa, sb, qa, qb); SCAN_PERIOD(31, sb, sc, qb, qa);
        SCAN_GATE(zcur, 31);
        LBAR();
#undef SCAN_PERIOD
#undef SCAN_GATE
    }
#endif
}

__device__ __forceinline__ void p5_sample_gdn(Frame& F, int item) {
    const int b = item >> 2, hh = item & 3;
    LAS float* QS = (LAS float*)(F.lds + 0);
    LAS float* KS = QS + 512; LAS float* VS = KS + 512; LAS float* PART = VS + 512;
    LAS float* GB = PART + 16;
    LAS float* RED = GB + 8;
    LAS float* OS = RED + 512;
    const bf16* H = (const bf16*)(F.ws + WS_H); const float* gates = (const float*)(F.ws + WS_GATES); bf16* MIX = (bf16*)(F.ws + WS_MIX);
    const int tid = F.tid, lane = F.lane, t = tid >> 7, c = tid & 127;
    const size_t m = (size_t)MP + b * TS + t;
    float xv[3];
#pragma unroll
    for (int X = 0; X < 3; ++X) {
        const int col = X * 512 + hh * 128 + c; float acc = 0.f;
#pragma unroll
        for (int i = 0; i < 4; ++i) {
            const int r = t - 3 + i;
            const float raw = (r >= 0) ? bf2f(H[((size_t)MP + b * TS + r) * HPITCH + 1024 + col]) : inp(3)[((size_t)b * 3 + (3 + r)) * QKVD + col];
            acc += inp(14)[(size_t)i * QKVD + col] * raw;
            if (i == 3 && t >= 1) F.out[OUT_QKVS + ((size_t)b * 3 + (t - 1)) * QKVD + col] = raw;
        }
        xv[X] = siluf(acc);
    }
    const float sq = wave_sum(xv[0] * xv[0]), sk = wave_sum(xv[1] * xv[1]);
    if (lane == 0) { PART[F.wave] = sq; PART[8 + F.wave] = sk; }
    if (c == 0) { const float bl = gates[m * 8 + hh], al = gates[m * 8 + 4 + hh]; GB[t] = -expf(inp(15)[hh]) * softplus_f(al + inp(16)[hh]); GB[4 + t] = sigmoid_f(bl); }
    __syncthreads();
    {
        const float ssq = PART[2 * t] + PART[2 * t + 1], ssk = PART[8 + 2 * t] + PART[8 + 2 * t + 1];
        QS[t * 128 + c] = xv[0] * rsqrtf(ssq + RMS_EPS) * 0.08838834764831845f; KS[t * 128 + c] = xv[1] * rsqrtf(ssk + RMS_EPS); VS[t * 128 + c] = xv[2];
    }
    __syncthreads();
    const int dq = tid >> 7;
    const float* S0 = inp(4) + (size_t)item * 128 * 128;
    float S[32];
#pragma unroll
    for (int i = 0; i < 32; ++i) S[i] = __builtin_nontemporal_load(S0 + (size_t)(dq * 32 + i) * 128 + c);
    for (int tk = 0; tk < 4; ++tk) {
        const float eg = expf(GB[tk]), beta = GB[4 + tk];
        float kv = 0.f;
#pragma unroll
        for (int i = 0; i < 32; ++i) { S[i] *= eg; kv += S[i] * KS[tk * 128 + dq * 32 + i]; }
        RED[dq * 128 + c] = kv;
        __syncthreads();
        const float kvt = (RED[c] + RED[128 + c]) + (RED[256 + c] + RED[384 + c]);
        const float vn = beta * (VS[tk * 128 + c] - kvt);
        float o = 0.f;
#pragma unroll
        for (int i = 0; i < 32; ++i) { S[i] += KS[tk * 128 + dq * 32 + i] * vn; o += S[i] * QS[tk * 128 + dq * 32 + i]; }
        __syncthreads();
        RED[dq * 128 + c] = o;
        __syncthreads();
        if (dq == 0) OS[tk * 128 + c] = (RED[c] + RED[128 + c]) + (RED[256 + c] + RED[384 + c]);
        __syncthreads();
    }
    float* RS = F.out + OUT_RECS + (size_t)item * 128 * 128;
#pragma unroll
    for (int i = 0; i < 32; ++i) __builtin_nontemporal_store(S[i], RS + (size_t)(dq * 32 + i) * 128 + c);
    {
        const float o = OS[t * 128 + c];
        const float ss = wave_sum(o * o);
        if (lane == 0) PART[F.wave] = ss;
        __syncthreads();
        const float rms = rsqrtf((PART[2 * t] + PART[2 * t + 1]) * (1.0f / 128.0f) + RMS_EPS);
        const float z = bf2f(H[m * HPITCH + 2560 + hh * 128 + c]);
        MIX[m * DM + 512 + hh * 128 + c] = (bf16)f2bf(o * rms * z);
    }
    __syncthreads();
}

template <int TB, bool SAMPLE>
__device__ __forceinline__ void p5_conf_item(Frame& F, int b, int t0, const LAS float* cwl) {
    constexpr int T = SAMPLE ? TS : TP, R = TB + 30;
    const bf16* H = (const bf16*)(F.ws + WS_H); bf16* MIX = (bf16*)(F.ws + WS_MIX);
    int ln_ = F.lane; asm volatile("" : "+v"(ln_));
    const int ch0 = ln_ * 8;
    const size_t mbase = SAMPLE ? (size_t)MP + (size_t)b * TS : (size_t)b * TP;
    float* cout = F.out + (SAMPLE ? OUT_CONVS : OUT_CONVP) + (size_t)b * 30 * CCH;
    const bool wr_state = (t0 + TB == T);
    f32x2 acc[TB][4], wt[8][4];
#pragma unroll
    for (int i = 0; i < TB; ++i)
#pragma unroll
        for (int c = 0; c < 4; ++c) acc[i][c] = (f32x2){0.f, 0.f};
#pragma unroll
    for (int i = 0; i < 8; ++i)
#pragma unroll
        for (int c = 0; c < 4; ++c) wt[i][c] = (f32x2){0.f, 0.f};
    v4u nb[8]; v4u na = {0u, 0u, 0u, 0u}; f32x4 ns0 = {0.f, 0.f, 0.f, 0.f}, ns1 = {0.f, 0.f, 0.f, 0.f};
#pragma unroll
    for (int j = 0; j < 8; ++j) nb[j] = (v4u){0u, 0u, 0u, 0u};
    if (!SAMPLE) {
#pragma unroll
        for (int j = 0; j < 8; ++j) { const int tt = t0 - 30 + j, tc = tt < 0 ? 0 : tt; nb[j] = *(const v4u*)(H + (mbase + tc) * HPITCH + ch0); }
    } else {
        const int tt = t0 - 30;
        if (tt >= 0) na = *(const v4u*)(H + (mbase + tt) * HPITCH + ch0);
        else { const f32x4* sp = (const f32x4*)(inp(2) + ((size_t)b * 30 + (30 + tt)) * CCH + ch0); ns0 = sp[0]; ns1 = sp[1]; }
    }
#pragma unroll 1
    for (int r8 = 0; r8 < (R + 7) / 8; ++r8) {
        v4u cbk[8];
        if (!SAMPLE) {
#pragma unroll
            for (int j = 0; j < 8; ++j) cbk[j] = nb[j];
#pragma unroll
            for (int j = 0; j < 8; ++j) { const int r = 8 * (r8 + 1) + j, tt = t0 - 30 + r, tc = tt < 0 ? 0 : (tt > T - 1 ? T - 1 : tt); nb[j] = *(const v4u*)(H + (mbase + tc) * HPITCH + ch0); }
        }
#pragma unroll
        for (int j = 0; j < 8; ++j) {
            const int r = 8 * r8 + j, tt = t0 - 30 + r;
            const v4u ca = SAMPLE ? na : cbk[j]; const f32x4 cs0 = ns0, cs1 = ns1;
            if (SAMPLE && r + 1 < R) {
                const int tn = tt + 1;
                if (tn >= 0) na = *(const v4u*)(H + (mbase + tn) * HPITCH + ch0);
                else { const f32x4* sp = (const f32x4*)(inp(2) + ((size_t)b * 30 + (30 + tn)) * CCH + ch0); ns0 = sp[0]; ns1 = sp[1]; }
            }
            { const int ir = r <= 30 ? r : 31;
              const f32x4 w0 = *(const LAS f32x4*)(cwl + ir * CCH + ch0), w1 = *(const LAS f32x4*)(cwl + ir * CCH + ch0 + 4);
              wt[j][0] = (f32x2){w0[0], w0[1]}; wt[j][1] = (f32x2){w0[2], w0[3]}; wt[j][2] = (f32x2){w1[0], w1[1]}; wt[j][3] = (f32x2){w1[2], w1[3]}; }
            float u[8];
            if (!SAMPLE) {
                const unsigned mk = (r < R && tt >= 0) ? 0xffffffffu : 0u;
                v4u cm = ca; cm.x &= mk; cm.y &= mk; cm.z &= mk; cm.w &= mk; unpack8(cm, u);
            } else if (r >= R) {
#pragma unroll
                for (int c = 0; c < 8; ++c) u[c] = 0.f;
            } else if (tt >= 0) {
                unpack8(ca, u);
            } else if (SAMPLE) {
                u[0] = cs0[0]; u[1] = cs0[1]; u[2] = cs0[2]; u[3] = cs0[3]; u[4] = cs1[0]; u[5] = cs1[1]; u[6] = cs1[2]; u[7] = cs1[3];
            } else {
#pragma unroll
                for (int c = 0; c < 8; ++c) u[c] = 0.f;
            }
            if (wr_state && r < R && tt >= T - 30) { f32x4* op = (f32x4*)(cout + (size_t)(tt - (T - 30)) * CCH + ch0); op[0] = (f32x4){u[0], u[1], u[2], u[3]}; op[1] = (f32x4){u[4], u[5], u[6], u[7]}; }
            const f32x2 u2[4] = {(f32x2){u[0], u[1]}, (f32x2){u[2], u[3]}, (f32x2){u[4], u[5]}, (f32x2){u[6], u[7]}};
#pragma unroll
            for (int to = 0; to < TB; ++to) {
                const int sl = (j - to) & 7;
#pragma unroll
                for (int c = 0; c < 4; ++c) acc[to][c] += wt[sl][c] * u2[c];
            }
            if (SAMPLE) asm volatile("" ::: "memory");
        }
    }
    float cb[8], lg[8], lb[8];
#pragma unroll
    for (int c = 0; c < 8; ++c) { cb[c] = inp(11)[ch0 + c]; lg[c] = inp(12)[ch0 + c]; lb[c] = inp(13)[ch0 + c]; }
#pragma unroll
    for (int to = 0; to < TB; ++to) {
        float v[8]; float s = 0.f;
#pragma unroll
        for (int c = 0; c < 8; ++c) { v[c] = acc[to][c >> 1][c & 1] + cb[c]; s += v[c]; }
        const float mean = wave_sum(s) * (1.0f / CCH); float q = 0.f;
#pragma unroll
        for (int c = 0; c < 8; ++c) { v[c] -= mean; q += v[c] * v[c]; }
        const float rstd = rsqrtf(wave_sum(q) * (1.0f / CCH) + LN_EPS);
        float y[8];
#pragma unroll
        for (int c = 0; c < 8; ++c) y[c] = siluf(v[c] * rstd * lg[c] + lb[c]);
        *(v4u*)(MIX + (mbase + t0 + to) * DM + ch0) = pack8(y);
    }
}

constexpr int CT_WIN = 65536;
template <bool SAMPLE>
__device__ __forceinline__ void p5_conf_tile(Frame& F, int b, int t0, const LAS float* cwl) {
    constexpr int T = SAMPLE ? TS : TP;
    const bf16* H = (const bf16*)(F.ws + WS_H); bf16* MIX = (bf16*)(F.ws + WS_MIX);
    int tq_ = threadIdx.x; asm volatile("" : "+v"(tq_));
    const int tid = tq_, lane = tid & 63, wv = __builtin_amdgcn_readfirstlane(tid >> 6);
    const size_t mbase = SAMPLE ? (size_t)MP + (size_t)b * TS : (size_t)b * TP;
    float* cout = F.out + (SAMPLE ? OUT_CONVS : OUT_CONVP) + (size_t)b * 30 * CCH;
    LAS unsigned char* win = F.lds + CT_WIN;
    if (!SAMPLE) {
        v4u rw[8];
#pragma unroll
        for (int i = 0; i < 8; ++i) { const int q = tid + 512 * i, row = q >> 6, chunk = q & 63, tt = t0 - 30 + row, tc = tt < 0 ? 0 : (tt > T - 1 ? T - 1 : tt);
            rw[i] = *(const v4u*)(H + (mbase + tc) * HPITCH + chunk * 8); }
#pragma unroll
        for (int i = 0; i < 8; ++i) { const int q = tid + 512 * i, row = q >> 6, chunk = q & 63, tt = t0 - 30 + row;
            v4u v = rw[i]; if (tt < 0) v = (v4u){0u, 0u, 0u, 0u};
            *(LAS v4u*)(win + row * 1024 + chunk * 16) = v;
            if (t0 + 32 == T && tt >= T - 30 && tt < T) { float u[8]; unpack8(v, u); f32x4* op = (f32x4*)(cout + (size_t)(tt - (T - 30)) * CCH + chunk * 8); op[0] = (f32x4){u[0], u[1], u[2], u[3]}; op[1] = (f32x4){u[4], u[5], u[6], u[7]}; } }
    } else {
        f32x4 sa[4], sb[4]; v4u hv = {0u, 0u, 0u, 0u};
#pragma unroll
        for (int i = 0; i < 4; ++i) { const int q = tid + 512 * i, row = q >> 6, chunk = q & 63; const int rc = row < 30 ? row : 29;
            const f32x4* sp = (const f32x4*)(inp(2) + ((size_t)b * 30 + rc) * CCH + chunk * 8); sa[i] = __builtin_nontemporal_load(sp); sb[i] = __builtin_nontemporal_load(sp + 1); }
        const int hrow = tid >> 6, hchunk = tid & 63;
        if (tid < 256) hv = *(const v4u*)(H + (mbase + hrow) * HPITCH + hchunk * 8);
#pragma unroll
        for (int i = 0; i < 4; ++i) { const int q = tid + 512 * i, row = q >> 6, chunk = q & 63;
            if (row < 30) { const float f[8] = {sa[i][0], sa[i][1], sa[i][2], sa[i][3], sb[i][0], sb[i][1], sb[i][2], sb[i][3]};
                *(LAS v4u*)(win + row * 1024 + chunk * 16) = pack8(f);
                if (row >= 4) { f32x4* op = (f32x4*)(cout + (size_t)(row - 4) * CCH + chunk * 8); op[0] = sa[i]; op[1] = sb[i]; } } }
        if (tid < 256) { *(LAS v4u*)(win + (30 + hrow) * 1024 + hchunk * 16) = hv;
            float u[8]; unpack8(hv, u); f32x4* op = (f32x4*)(cout + (size_t)(26 + hrow) * CCH + hchunk * 8); op[0] = (f32x4){u[0], u[1], u[2], u[3]}; op[1] = (f32x4){u[4], u[5], u[6], u[7]}; }
        if (tid < 384) *(LAS v4u*)(win + (34 + (tid >> 6)) * 1024 + (tid & 63) * 16) = (v4u){0u, 0u, 0u, 0u};
    }
    __syncthreads();
    if (!SAMPLE || wv == 0) {
        const int ch0 = lane * 8, wrow0 = SAMPLE ? 0 : 4 * wv;
        const LAS unsigned char* wl = win + ch0 * 2;
        f32x2 acc[4][4], wt[8][4];
#pragma unroll
        for (int i = 0; i < 4; ++i)
#pragma unroll
            for (int c = 0; c < 4; ++c) acc[i][c] = (f32x2){0.f, 0.f};
#pragma unroll
        for (int i = 0; i < 8; ++i)
#pragma unroll
            for (int c = 0; c < 4; ++c) wt[i][c] = (f32x2){0.f, 0.f};
#pragma unroll 1
        for (int r8 = 0; r8 < 5; ++r8) {
#pragma unroll
            for (int j = 0; j < 8; ++j) {
                const int r = 8 * r8 + j; int lr = wrow0 + r; lr = lr > 63 ? 63 : lr;
                const v4u ca = *(const LAS v4u*)(wl + lr * 1024);
                { const int ir = r <= 30 ? r : 31;
                  const f32x4 w0 = *(const LAS f32x4*)(cwl + ir * CCH + ch0), w1 = *(const LAS f32x4*)(cwl + ir * CCH + ch0 + 4);
                  wt[j][0] = (f32x2){w0[0], w0[1]}; wt[j][1] = (f32x2){w0[2], w0[3]}; wt[j][2] = (f32x2){w1[0], w1[1]}; wt[j][3] = (f32x2){w1[2], w1[3]}; }
                float u[8]; unpack8(ca, u);
                const f32x2 u2[4] = {(f32x2){u[0], u[1]}, (f32x2){u[2], u[3]}, (f32x2){u[4], u[5]}, (f32x2){u[6], u[7]}};
#pragma unroll
                for (int to = 0; to < 4; ++to) {
                    const int sl = (j - to) & 7;
#pragma unroll
                    for (int c = 0; c < 4; ++c) acc[to][c] += wt[sl][c] * u2[c];
                }
            }
        }
        float cb[8], lg[8], lb[8];
#pragma unroll
        for (int c = 0; c < 8; ++c) { cb[c] = inp(11)[ch0 + c]; lg[c] = inp(12)[ch0 + c]; lb[c] = inp(13)[ch0 + c]; }
#pragma unroll
        for (int to = 0; to < 4; ++to) {
            float v[8]; float sm = 0.f;
#pragma unroll
            for (int c = 0; c < 8; ++c) { v[c] = acc[to][c >> 1][c & 1] + cb[c]; sm += v[c]; }
            const float mean = wave_sum(sm) * (1.0f / CCH); float q = 0.f;
#pragma unroll
            for (int c = 0; c < 8; ++c) { v[c] -= mean; q += v[c] * v[c]; }
            const float rstd = rsqrtf(wave_sum(q) * (1.0f / CCH) + LN_EPS);
            float y[8];
#pragma unroll
            for (int c = 0; c < 8; ++c) y[c] = siluf(v[c] * rstd * lg[c] + lb[c]);
            *(v4u*)(MIX + (mbase + t0 + wrow0 + to) * DM + ch0) = pack8(y);
        }
    }
    __syncthreads();
}

__device__ __forceinline__ void p2b_sample_rows(Frame& F, int gw, int NGW) {
    const bf16* XB = (const bf16*)(F.ws + WS_XB); const float* SL = (const float*)(F.ws + WS_SLAB1); bf16* Z1 = (bf16*)(F.out + OUT_Y); float* st1 = (float*)(F.ws + WS_ST1);
    for (int m = MP + gw; m < MTOT; m += NGW) {
        const v4u* xr = (const v4u*)(XB + (size_t)m * DM) + F.lane; float x[16]; unpack8(xr[0], x); unpack8(xr[64], x + 8);
        float z[16], s = 0.f, q = 0.f;
#pragma unroll
        for (int j = 0; j < 2; ++j)
#pragma unroll
            for (int e4 = 0; e4 < 2; ++e4) {
                const int col = 512 * j + 8 * F.lane + 4 * e4;
                f32x4 a = {0.f, 0.f, 0.f, 0.f};
#pragma unroll
                for (int sl = 0; sl < 4; ++sl) a = a + *(const f32x4*)(SL + ((size_t)sl * 512 + (m - MP)) * 1024 + col);
#pragma unroll
                for (int e = 0; e < 4; ++e) { const float zz = x[8 * j + 4 * e4 + e] * 1.189207115002721f + a[e]; z[8 * j + 4 * e4 + e] = zz; s += zz; q += zz * zz; }
            }
        s = wave_sum(s); q = wave_sum(q);
        v4u* zr = (v4u*)(Z1 + (size_t)m * DM) + F.lane; zr[0] = pack8(z); zr[64] = pack8(z + 8);
        if (F.lane == 0) { st1[2 * m] = s; st1[2 * m + 1] = q; }
    }
}

__device__ __forceinline__ void p9_final_ln(Frame& F, int row_lo, int row_hi, int gw, int NGW, bool slabs) {
    const bf16* Z3 = (const bf16*)(F.ws + WS_Z2);
    f32x4 gv[4], bv[4];
#pragma unroll
    for (int j = 0; j < 2; ++j) { gv[2 * j] = *(const f32x4*)(inp(23) + 512 * j + 8 * F.lane); gv[2 * j + 1] = *(const f32x4*)(inp(23) + 512 * j + 8 * F.lane + 4);
                                   bv[2 * j] = *(const f32x4*)(inp(24) + 512 * j + 8 * F.lane); bv[2 * j + 1] = *(const f32x4*)(inp(24) + 512 * j + 8 * F.lane + 4); }
    for (int m = row_lo + gw; m < row_hi; m += NGW) {
        const v4u* zr = (const v4u*)(Z3 + (size_t)m * DM) + F.lane;
        float v[16];
        if (slabs && m >= MP) {
            const bf16* Z2 = (const bf16*)(F.ws + WS_Z2B); const float* st2 = (const float*)(F.ws + WS_ST2); const float* SL = (const float*)(F.ws + WS_SLAB);
            const v4u* z2r = (const v4u*)(Z2 + (size_t)m * DM) + F.lane; float z2[16]; unpack8(z2r[0], z2); unpack8(z2r[64], z2 + 8);
            const float mean2 = st2[2 * m] * (1.0f / 1024.0f), var2 = st2[2 * m + 1] * (1.0f / 1024.0f) - mean2 * mean2, rstd2 = rsqrtf(fmaxf(var2, 0.f) + LN_EPS);
#pragma unroll
            for (int j = 0; j < 2; ++j)
#pragma unroll
                for (int e4 = 0; e4 < 2; ++e4) {
                    const int col = 512 * j + 8 * F.lane + 4 * e4;
                    const f32x4 g2 = *(const f32x4*)(inp(19) + col), b2 = *(const f32x4*)(inp(20) + col);
                    f32x4 a = {0.f, 0.f, 0.f, 0.f};
#pragma unroll
                    for (int sl = 0; sl < 4; ++sl) a = a + *(const f32x4*)(SL + ((size_t)sl * 512 + (m - MP)) * 1024 + col);
#pragma unroll
                    for (int e = 0; e < 4; ++e) v[8 * j + 4 * e4 + e] = ((z2[8 * j + 4 * e4 + e] - mean2) * rstd2 * g2[e] + b2[e]) * 1.189207115002721f + a[e];
                }
        } else { unpack8(zr[0], v); unpack8(zr[64], v + 8); }
        float s = 0.f;
#pragma unroll
        for (int i = 0; i < 16; ++i) s += v[i];
        const float mean = wave_sum(s) * (1.f / DM); float s2 = 0.f;
#pragma unroll
        for (int i = 0; i < 16; ++i) { v[i] -= mean; s2 += v[i] * v[i]; }
        const float rstd = rsqrtf(wave_sum(s2) * (1.f / DM) + LN_EPS);
        float* orow = F.out + (size_t)m * DM;
#pragma unroll
        for (int j = 0; j < 2; ++j) {
            f32x4 o0, o1;
#pragma unroll
            for (int e = 0; e < 4; ++e) { o0[e] = v[8 * j + e] * rstd * gv[2 * j][e] + bv[2 * j][e]; o1[e] = v[8 * j + 4 + e] * rstd * gv[2 * j + 1][e] + bv[2 * j + 1][e]; }
            __builtin_nontemporal_store(o0, (f32x4*)(orow + 512 * j + 8 * F.lane)); __builtin_nontemporal_store(o1, (f32x4*)(orow + 512 * j + 8 * F.lane + 4));
        }
    }
}

struct Args { const float* in[25]; float* out; unsigned char* ws; };
__global__ void __launch_bounds__(NWAVES * 64, 2) hymba_fwd(Args args) {
    extern __shared__ __attribute__((aligned(16))) unsigned char lds[];
    Frame F;
    F.lds = (LAS unsigned char*)lds;
    F.MISC = (volatile LAS unsigned*)(F.lds + MISC_OFF);
    F.tid = threadIdx.x; F.lane = F.tid & 63; F.wave = __builtin_amdgcn_readfirstlane(F.tid >> 6);
    F.G = gridDim.x; { const int bx = blockIdx.x; F.vcu = (F.G % 8 == 0) ? (bx % 8) * (F.G / 8) + bx / 8 : bx; }
    F.ws = args.ws; F.out = args.out; F.ctl = (gu32*)(args.ws + WS_CTL);
    for (int u = F.tid; u < (LDS_BYTES - MISC_OFF) / 4; u += NWAVES * 64) ((LAS unsigned*)(F.lds + MISC_OFF))[u] = 0u;
    __syncthreads();
    XcdBarrier bar = xcd_barrier_post((unsigned*)(F.ctl + CW_BAR), F.MISC + 8);
    if (threadIdx.x == 0) __hip_atomic_store((unsigned*)(F.ctl + CW_XCC) + blockIdx.x, xb_xcc_id() + 1u, RLX_AGENT);
#define GRID_BAR() do { xcd_barrier(bar); int t_ = threadIdx.x; asm volatile("" : "+v"(t_)); F.tid = t_; F.lane = t_ & 63; F.wave = __builtin_amdgcn_readfirstlane(t_ >> 6); } while (0)
    unsigned char* ws = args.ws;
    const int G = F.G, bx = blockIdx.x;

#ifndef PHM
#define PHM 0x3ff
#endif
#define PH(k) ((PHM >> (k)) & 1)
#ifndef DUPM
#define DUPM 0
#endif
#define REP(k) (1 + ((DUPM >> (k)) & 1))
#ifndef DUP5
#define DUP5 0
#endif
#ifndef P5M
#define P5M 15
#endif
#if PH(0)
    p0_prologue(F);
#endif
    GRID_BAR();
    if (G == 256 && bx >= 32 && threadIdx.x == 0) {
        const unsigned mine = xb_xcc_id() + 1u, scn = __hip_atomic_load((unsigned*)(F.ctl + CW_XCC) + ((bx - 32) & 31), RLX_AGENT);
        const unsigned x8 = __hip_atomic_load((unsigned*)(F.ctl + CW_XCC) + (bx & 7), RLX_AGENT);
        if (mine != scn || mine != x8) __hip_atomic_fetch_or((unsigned*)(F.ctl + CW_VIOL), 1u, RLX_AGENT);
    }
#if PH(1)
    for (int rep = 0; rep < REP(1); ++rep) {
    {
        pg8::Gemm g{(const bf16*)(ws + WS_XB), (const bf16*)(ws + WS_WUP1), MTOT, NUP, DM}; pg8::StaticOrder S; S.init(MTOT, NUP, G, bx);
        pg8::EpiSwiGLU<false> E{(bf16*)(ws + WS_HID), nullptr, nullptr, nullptr};
        pg8::gemm_phase<pg8::EpiSwiGLU<false>, pg8::StaticOrder, true, true>(F.lds + RING_OFF, g, S, E);
        if (rep == 0) { if (G == 256) { if (bx >= 172) p0_weights<2>(F, (bx - 172) * NWAVES + F.wave, (G - 172) * NWAVES); } else p0_weights<2>(F, bx * NWAVES + F.wave, G * NWAVES); }
    }
    GRID_BAR();
    }
#endif

#if PH(2)
    for (int rep = 0; rep < REP(2); ++rep) {
    {
        pg8::Gemm g{(const bf16*)(ws + WS_HID), (const bf16*)(ws + WS_WDN1), MTOT, DM, DFF}; pg8::TailOrder S; S.init(MTOT, DM, G, bx, 3);
        pg8::EpiZ<0> E{(const float*)(ws + WS_SLAB1), nullptr, (const bf16*)(ws + WS_XB), nullptr, nullptr, nullptr, (bf16*)(F.out + OUT_Y), (float*)(ws + WS_ST1), 0.5f};
        pg8::gemm_phase<pg8::EpiZ<0>, pg8::TailOrder, true, true>(F.lds + RING_OFF, g, S, E);
        if (rep == 0) { if (G == 256) { if (bx >= 128) p0_weights<1>(F, (bx - 128) * NWAVES + F.wave, (G - 128) * NWAVES); } else p0_weights<1>(F, bx * NWAVES + F.wave, G * NWAVES); }
    }
    GRID_BAR();
    }
#endif

    if (G == 256) { p2b_sample_rows(F, bx * NWAVES + F.wave, G * NWAVES); GRID_BAR(); }
#ifdef FORCE_UNFUSED
#define FUSED45() false
#else
#define FUSED45() ((F.G == 256) && (__hip_atomic_load((unsigned*)(F.ctl + CW_VIOL), RLX_AGENT) == 0u))
#endif
    const bool fused45 = FUSED45();
#if PH(3)
    {
        unsigned* ecnt = (unsigned*)(F.ctl + CW_QCTR) + 256;
        pg8::Gemm g{(const bf16*)(F.out + OUT_Y), (const bf16*)(ws + WS_WIN), MTOT, NIN, DM}; pg8::AlignedInOrder S; S.init(MTOT, NIN, G, bx, ecnt); if (!fused45) S.special = false;
        pg8::EpiH E{(bf16*)(ws + WS_H), (float*)(ws + WS_GATES), (const float*)(ws + WS_ST1), (const float*)(ws + WS_CSIN), (const float*)(ws + WS_BWIN), inp(17)};
        pg8::gemm_phase<pg8::EpiH, pg8::AlignedInOrder, true, true>(F.lds + RING_OFF, g, S, E);
        if (fused45 && (bx >> 3) >= 22) {
            const int x = bx & 7, e = (bx >> 3) - 22;
            while (__hip_atomic_load(ecnt + 16 * x, RLX_AGENT) < 112u) __builtin_amdgcn_s_sleep(16);
#pragma unroll 1
            for (int j = e; j < 28; j += 10) p4_run(F, ((x * 32 + (j >> 2)) * 4) + (j & 3), 0, 1, true);
        }
    }
    GRID_BAR();
#endif

#if PH(4)
    {
        const bool fused = fused45;
        int ch0, st4, ni4;
        if (fused) { const int c4 = bx - 32, bhp = c4 & 31, n0 = c4 >> 5; ch0 = ((bhp >> 2) * 32 + n0 + 7) * 4 + (bhp & 3); st4 = 28; ni4 = (bx < 32) ? 0 : (n0 <= 3 ? 4 : 3); }
        else { ch0 = bx; st4 = G; ni4 = (NCH - bx + G - 1) / G; }
        p4_run(F, ch0, st4, ni4, fused);
        if (!fused) GRID_BAR();
        const bool split = (G >= 64); const int nscan = split ? 32 : G, noth = split ? G - 32 : G, oid = split ? bx - 32 : bx;
        { int t_ = threadIdx.x; asm volatile("" : "+v"(t_)); F.tid = t_; F.lane = t_ & 63; F.wave = __builtin_amdgcn_readfirstlane(t_ >> 6); }
        if (!split || bx < 32) { for (int it = bx; it < NBP * NH; it += nscan) p5_scan(F, it, fused); }
        { int t_ = threadIdx.x; asm volatile("" : "+v"(t_)); F.tid = t_; F.lane = t_ & 63; F.wave = __builtin_amdgcn_readfirstlane(t_ >> 6); }
        {
            __syncthreads();
            LAS float* cwl = (LAS float*)(F.lds + 0);
            for (int i = F.tid; i < 32 * CCH / 4; i += NWAVES * 64) ((LAS f32x4*)cwl)[i] = (i < CWID * CCH / 4) ? ((const f32x4*)inp(10))[i] : (f32x4){0.f, 0.f, 0.f, 0.f};
            __syncthreads();
            unsigned* qc = (unsigned*)(F.ctl + CW_QCTR);
            const int nstat = split ? G - 32 : G;
            const int rank = !split ? bx : (bx < 32 ? -1 : (fused ? (oid >= 128 ? oid - 128 : oid + 96) : oid));
            constexpr int NCT = MP / 32 + NBS, NIT = NCT + NBS * NH;
            {
                unsigned raw = 0u;
                if (threadIdx.x == 0) F.MISC[20] = (rank >= 0) ? (unsigned)rank : (unsigned)nstat + __hip_atomic_fetch_add(qc, 1u, RLX_AGENT);
                __syncthreads();
                for (;;) {
                    const int it = (int)F.MISC[20];
                    if (it >= NIT) break;
                    if (threadIdx.x == 0) raw = (unsigned)nstat + __hip_atomic_fetch_add(qc, 1u, RLX_AGENT);
                    { int t_ = threadIdx.x; asm volatile("" : "+v"(t_)); F.tid = t_; F.lane = t_ & 63; F.wave = __builtin_amdgcn_readfirstlane(t_ >> 6); }
                    if (it < MP / 32) p5_conf_tile<false>(F, it >> 6, (it & 63) * 32, cwl);
                    else if (it < NCT) p5_conf_tile<true>(F, it - MP / 32, 0, cwl);
                    else p5_sample_gdn(F, it - NCT);
                    if (threadIdx.x == 0) F.MISC[20] = raw;
                    __syncthreads();
                }
            }
        }
    }
    GRID_BAR();
#endif

#if PH(6)
    {
        const bool f67 = FUSED45();
        unsigned* pc6 = (unsigned*)(F.ctl + CW_PCNT6); unsigned* uc6 = (unsigned*)(F.ctl + CW_UCNT6); unsigned* sc6 = (unsigned*)(F.ctl + CW_SCNT6);
        {
            pg8::Gemm g{(const bf16*)(ws + WS_MIX), (const bf16*)(ws + WS_WOUT), MTOT, DM, DM}; pg8::SigTailOrder S; S.init(MTOT, DM, G, bx, pc6, uc6, sc6, f67);
            pg8::EpiZ<1> E{nullptr, nullptr, (const bf16*)(F.out + OUT_Y), (const float*)(ws + WS_ST1), inp(7), inp(8), (bf16*)(ws + WS_Z2B), (float*)(ws + WS_ST2), 1.0f};
            pg8::gemm_phase<pg8::EpiZ<1>, pg8::SigTailOrder, true, true>(F.lds + RING_OFF, g, S, E);
        }
        if (!f67) GRID_BAR();
        {
            pg8::Gemm g{(const bf16*)(ws + WS_Z2B), (const bf16*)(ws + WS_WUP2), MTOT, NUP, DM}; pg8::GatedUp22 S; S.init(MTOT, NUP, G, bx, pc6, sc6, f67);
            pg8::EpiSwiGLU<true> E{(bf16*)(ws + WS_HID2), (const float*)(ws + WS_ST2), (const float*)(ws + WS_CSUP2), (const float*)(ws + WS_BWUP2)};
            pg8::gemm_phase<pg8::EpiSwiGLU<true>, pg8::GatedUp22, true, true>(F.lds + RING_OFF, g, S, E);
        }
    }
    GRID_BAR();
#endif

#if PH(8)
    for (int rep = 0; rep < REP(8); ++rep) {
    {
        pg8::Gemm g{(const bf16*)(ws + WS_HID2), (const bf16*)(ws + WS_WDN2), MTOT, DM, DFF}; pg8::TailOrder S; S.init(MTOT, DM, G, bx, 3);
        pg8::EpiZ<2> E{(const float*)(ws + WS_SLAB), nullptr, (const bf16*)(ws + WS_Z2B), (const float*)(ws + WS_ST2), inp(19), inp(20), (bf16*)(ws + WS_Z2), nullptr, 0.5f};
        pg8::gemm_phase<pg8::EpiZ<2>, pg8::TailOrder, true, true>(F.lds + RING_OFF, g, S, E);
    }
    GRID_BAR();
    }
#endif
#if PH(9)
    p9_final_ln(F, 0, MTOT, F.vcu * NWAVES + F.wave, F.G * NWAVES, F.G == 256);
#endif
}

extern "C" void kernel_launch(void* const* d_in, const int* in_sizes, int n_in, void* d_out, int out_size, void* d_ws, size_t ws_size, hipStream_t stream) {
    static int grid = 0;
    if (grid == 0) {
        if (n_in != 25 || in_sizes[0] != MP * DM || (size_t)out_size != OUT_TOTAL || ws_size < WS_END) { fprintf(stderr, "kernel_launch: unexpected shapes (n_in %d, in0 %d, out %d, ws %zu)\n", n_in, n_in > 0 ? in_sizes[0] : -1, out_size, ws_size); grid = -1; return; }
        int dev = 0, cus = 0, per_cu = 0;
        if (hipGetDevice(&dev) != hipSuccess || hipDeviceGetAttribute(&cus, hipDeviceAttributeMultiprocessorCount, dev) != hipSuccess) { grid = -1; return; }
        if (hipFuncSetAttribute((const void*)hymba_fwd, hipFuncAttributeMaxDynamicSharedMemorySize, LDS_BYTES) != hipSuccess) { fprintf(stderr, "kernel_launch: hipFuncSetAttribute failed\n"); grid = -1; return; }
        if (hipOccupancyMaxActiveBlocksPerMultiprocessor(&per_cu, (const void*)hymba_fwd, NWAVES * 64, LDS_BYTES) != hipSuccess || per_cu < 1) { fprintf(stderr, "kernel_launch: occupancy query says %d blocks per CU\n", per_cu); per_cu = 1; }
        (void)hipGetLastError();
        grid = cus;
    }
    if (grid < 0) return;
    (void)hipMemsetAsync((char*)d_ws + WS_CTL, 0, CTL_ZERO_BYTES, stream);
    Args a{};
    for (int i = 0; i < 25; ++i) a.in[i] = (const float*)d_in[i];
    a.out = (float*)d_out; a.ws = (unsigned char*)d_ws;
    hipLaunchKernelGGL(hymba_fwd, dim3(grid), dim3(NWAVES * 64), LDS_BYTES, stream, a);
}
```
